# Optimizing an MI355X kernel written in HIP

```python
import math
import jax, jax.numpy as jnp
from jax import lax
import numpy as np

D_MODEL = 2048
BATCH = 1
SEQ = 8192
DEPTH = 1

N_HEADS = 16
QK_NOPE_DIM = 128
ROPE_DIM = 64
V_HEAD_DIM = 128
Q_LORA_RANK = 512
KV_LORA_RANK = 512
MLA_WIDTH = N_HEADS * V_HEAD_DIM
CONV_WIDTH = D_MODEL
CONV_K = 3
ROPE_THETA = 10000.0
RMS_EPS = 1e-6
BLOCK_Q = 128

IN_SPLIT = [
    Q_LORA_RANK,
    KV_LORA_RANK,
    ROPE_DIM,
    MLA_WIDTH,
    CONV_WIDTH,
    CONV_WIDTH,
    CONV_WIDTH,
    CONV_WIDTH,
    D_MODEL,
    D_MODEL,
]
IN_TOTAL = sum(IN_SPLIT)

kernel_name = "hybrid_mla_shortconv_gated_merge"


def _rmsnorm(x, g):
    xf = x.astype(jnp.float32)
    r = lax.rsqrt(jnp.mean(xf * xf, axis=-1, keepdims=True) + RMS_EPS)
    return (xf * r * g.astype(jnp.float32)).astype(x.dtype)


def _rope_tables(positions):
    inv_freq = ROPE_THETA ** (-jnp.arange(0, ROPE_DIM, 2, dtype=jnp.float32) / ROPE_DIM)
    ang = positions.astype(jnp.float32)[..., None] * inv_freq
    return jnp.cos(ang), jnp.sin(ang)


def _apply_rope(x, cos, sin):
    xf = x.astype(jnp.float32)
    x1, x2 = jnp.split(xf, 2, axis=-1)
    out = jnp.concatenate([x1 * cos - x2 * sin, x1 * sin + x2 * cos], axis=-1)
    return out.astype(x.dtype)


def _causal_mla_attention(q_nope, q_rope, k_nope, k_rope, v):
    b, s, h, _ = q_nope.shape
    nb = s // BLOCK_Q
    scale = 1.0 / math.sqrt(QK_NOPE_DIM + ROPE_DIM)
    qn_blocks = q_nope.reshape(b, nb, BLOCK_Q, h, QK_NOPE_DIM).transpose(1, 0, 2, 3, 4)
    qr_blocks = q_rope.reshape(b, nb, BLOCK_Q, h, ROPE_DIM).transpose(1, 0, 2, 3, 4)
    key_pos = jnp.arange(s, dtype=jnp.int32)

    def one_block(args):
        qn, qr, blk = args
        sc = (jnp.einsum('bqhd,bkhd->bhqk', qn, k_nope)
              + jnp.einsum('bqhr,bkr->bhqk', qr, k_rope)).astype(jnp.float32) * scale
        q_pos = blk * BLOCK_Q + jnp.arange(BLOCK_Q, dtype=jnp.int32)
        mask = key_pos[None, :] <= q_pos[:, None]
        sc = jnp.where(mask[None, None], sc, -jnp.inf)
        p = jax.nn.softmax(sc, axis=-1).astype(v.dtype)
        return jnp.einsum('bhqk,bkhd->bqhd', p, v)

    out = lax.map(one_block, (qn_blocks, qr_blocks, jnp.arange(nb, dtype=jnp.int32)))
    return out.transpose(1, 0, 2, 3, 4).reshape(b, s, h, V_HEAD_DIM)


def setup_inputs(seed: int = 0) -> dict:
    key = jax.random.key(seed)
    ks = jax.random.split(key, 16)
    f32 = jnp.float32

    def w(k, shape, fan_in):
        return jax.random.normal(k, shape, f32) * (fan_in ** -0.5)

    def gain(k, n):
        return 1.0 + 0.02 * jax.random.normal(k, (n,), f32)

    x = jax.random.normal(ks[0], (BATCH, SEQ, D_MODEL), f32)
    start = jax.random.randint(ks[1], (BATCH, 1), 0, 1024, dtype=jnp.int32)
    positions = start + jnp.arange(SEQ, dtype=jnp.int32)[None, :]
    return {
        "x": x,
        "positions": positions,
        "pre_norm_g": gain(ks[2], D_MODEL),
        "w_in": w(ks[3], (D_MODEL, IN_TOTAL), D_MODEL),
        "q_a_norm_g": gain(ks[4], Q_LORA_RANK),
        "w_q_b": w(ks[5], (Q_LORA_RANK, N_HEADS * (QK_NOPE_DIM + ROPE_DIM)), Q_LORA_RANK),
        "kv_a_norm_g": gain(ks[6], KV_LORA_RANK),
        "w_kv_b": w(ks[7], (KV_LORA_RANK, N_HEADS * (QK_NOPE_DIM + V_HEAD_DIM)), KV_LORA_RANK),
        "conv_w": w(ks[8], (CONV_K, CONV_WIDTH), CONV_K),
        "w_o_mla": w(ks[9], (MLA_WIDTH, D_MODEL), MLA_WIDTH),
        "w_o_conv": w(ks[10], (CONV_WIDTH, D_MODEL), CONV_WIDTH),
        "w_out": w(ks[11], (D_MODEL, D_MODEL), D_MODEL),
        "post_norm_g": gain(ks[12], D_MODEL),
    }


def reference(x, positions, pre_norm_g, w_in, q_a_norm_g, w_q_b, kv_a_norm_g, w_kv_b,
              conv_w, w_o_mla, w_o_conv, w_out, post_norm_g):
    b, s, _ = x.shape
    cos, sin = _rope_tables(positions)
    for _layer in range(DEPTH):
        h = _rmsnorm(x, pre_norm_g)
        proj = jnp.einsum('bsd,de->bse', h, w_in)
        cuts = [int(c) for c in np.cumsum(IN_SPLIT)[:-1]]
        (q_a, c_kv, k_rope, z_mla, c_in, b_gate, c_gate, z_conv,
         g_mla, g_conv) = jnp.split(proj, cuts, axis=-1)

        q = jnp.einsum('bsr,re->bse', _rmsnorm(q_a, q_a_norm_g), w_q_b)
        q = q.reshape(b, s, N_HEADS, QK_NOPE_DIM + ROPE_DIM)
        q_nope, q_rope = q[..., :QK_NOPE_DIM], q[..., QK_NOPE_DIM:]
        kv = jnp.einsum('bsr,re->bse', _rmsnorm(c_kv, kv_a_norm_g), w_kv_b)
        kv = kv.reshape(b, s, N_HEADS, QK_NOPE_DIM + V_HEAD_DIM)
        k_nope, v = kv[..., :QK_NOPE_DIM], kv[..., QK_NOPE_DIM:]
        q_rope = _apply_rope(q_rope, cos[:, :, None, :], sin[:, :, None, :])
        k_rope = _apply_rope(k_rope, cos, sin)
        attn = _causal_mla_attention(q_nope, q_rope, k_nope, k_rope, v)
        attn = attn.reshape(b, s, MLA_WIDTH) * jax.nn.silu(z_mla)
        y_mla = jnp.einsum('bse,ed->bsd', attn, w_o_mla)

        u = c_gate * c_in
        u_pad = jnp.pad(u, ((0, 0), (CONV_K - 1, 0), (0, 0)))
        conv = sum(conv_w[k] * u_pad[:, k:k + s] for k in range(CONV_K))
        y_conv = jnp.einsum('bse,ed->bsd', b_gate * conv * jax.nn.silu(z_conv), w_o_conv)

        merged = jax.nn.sigmoid(g_mla) * y_mla + jax.nn.sigmoid(g_conv) * y_conv
        out = jnp.einsum('bsd,de->bse', merged, w_out)
        x = x + _rmsnorm(out, post_norm_g)
    return x
```

```cpp
#define MK_N_LAUNCHES 1
#include <hip/hip_runtime.h>
#include <cstdio>
#include <cstdint>
#include <cstring>

constexpr int S = 8192, DM = 2048, NH = 16, QL = 512, KVL = 512;
constexpr int IN_TOTAL = 15424;
constexpr int C_QA = 0, C_CKV = 512, C_KR = 1024, C_ZM = 1088, C_CIN = 3136, C_BG = 5184, C_CG = 7232, C_ZC = 9280, C_GM = 11328, C_GC = 13376;
constexpr int N1P = 61 * 256;
constexpr int NQ = 3072, NKV = 4096;
constexpr float RMS_EPS = 1e-6f;
constexpr float QSCALE = 0.07216878364870322f * 1.4426950408889634f;

constexpr size_t MiB = 1u << 20;
constexpr size_t WS_CTL = 0, CTL_ZERO_BYTES = 1 * MiB;
constexpr size_t WS_SSQ = 512 * 1024;
constexpr size_t WS_ROPE = 2 * MiB;
constexpr size_t WS_WQT = 4 * MiB, WS_WKVT = 7 * MiB, WS_WOMT = 11 * MiB, WS_WOCT = 19 * MiB, WS_WOUTT = 27 * MiB, WS_WINT = 35 * MiB;
constexpr size_t WS_H = 96 * MiB;
constexpr size_t WS_AO = WS_H;
constexpr size_t WS_QA = 128 * MiB, WS_CKV = 136 * MiB, WS_KR = 144 * MiB;
constexpr size_t WS_ZS = 146 * MiB, WS_U = 178 * MiB, WS_T = 210 * MiB, WS_SG1 = 242 * MiB, WS_SG2 = 274 * MiB;
constexpr size_t WS_QN = 306 * MiB, WS_QR = 338 * MiB, WS_KN = 354 * MiB, WS_V = 386 * MiB;
constexpr size_t WS_AC = 418 * MiB, WS_END = 450 * MiB;
constexpr size_t WS_MG = WS_U;
constexpr size_t WS_OUTF = WS_QN;
static_assert(WS_WINT + (size_t)N1P * DM * 2 <= WS_H, "ws map");

typedef unsigned short bf16_t;
typedef unsigned v4u __attribute__((ext_vector_type(4)));
#define GAS __attribute__((address_space(1)))
#define LAS __attribute__((address_space(3)))
__device__ __forceinline__ float bf2f(bf16_t v) { return __uint_as_float((unsigned)v << 16); }
__device__ __forceinline__ bf16_t f2bf(float f) { unsigned u = __float_as_uint(f); return (bf16_t)((u + 0x7fffu + ((u >> 16) & 1u)) >> 16); }
__device__ __forceinline__ unsigned pk2(float lo, float hi) { return (unsigned)f2bf(lo) | ((unsigned)f2bf(hi) << 16); }
__device__ __forceinline__ float silu_f(float v) { return v / (1.f + expf(-v)); }
__device__ __forceinline__ float sigm_f(float v) { return 1.f / (1.f + expf(-v)); }
__device__ __forceinline__ float fsigm(float v) { return __builtin_amdgcn_rcpf(1.f + __builtin_amdgcn_exp2f(-1.4426950408889634f * v)); }
__device__ __forceinline__ float wave_sum(float v) {
#pragma unroll
    for (int o = 1; o < 64; o <<= 1) v += __shfl_xor(v, o);
    return v;
}
template <int MAP> __device__ __forceinline__ int srcmap(int np) {
    if (MAP == 1) {
        const int t = np >> 8, c = np & 255;
        if (t < 4) return np;
        if (t == 4) return (c & 127) < 32 ? C_KR + 32 * (c >> 7) + (c & 127) : -1;
        if (t < 13) return C_ZM + np - 5 * 256;
        if (t < 45) { const int tt = t - 13, kind = 2 * (c >> 7) + ((c >> 2) & 1), ch = 64 * tt + 4 * ((c & 127) >> 3) + (c & 3);
            return (kind == 0 ? C_CIN : kind == 1 ? C_BG : kind == 2 ? C_CG : C_ZC) + ch; }
        if (t < 53) return C_GM + np - 45 * 256;
        return C_GC + np - 53 * 256;
    }
    if (MAP == 2) {
        if (np < 2048) return 192 * (np >> 7) + (np & 127);
        const int t = (np - 2048) >> 8, c = np & 255, head = 4 * t + ((c & 127) >> 5);
        return 192 * head + 128 + 32 * (c >> 7) + (c & 31);
    }
    if (MAP == 3) { const int h = (np & 2047) >> 7, d = np & 127; return 256 * h + (np >= 2048 ? 128 : 0) + d; }
    return np;
}

namespace pg8 {
#define PG8_LAS __attribute__((address_space(3)))
typedef unsigned short bf16_t;
typedef short bf16x8 __attribute__((ext_vector_type(8)));
typedef float f32x4 __attribute__((ext_vector_type(4)));
typedef unsigned u32x4 __attribute__((ext_vector_type(4)));
constexpr int BM = 256, BK = 64, HALF = 128, HTB = HALF * BK * 2  , STAGE_BYTES = 8 * HTB, NXCD = 8, WGM = 8;

__host__ __device__ __forceinline__ int lds_byte(int r, int c) { const int st = (r >> 4) * 2 + (c >> 5), rr = r & 15, cc = c & 31, ob = rr * 64 + cc * 2; return st * 1024 + (ob ^ (((ob >> 9) & 1) << 5)); }
__host__ __device__ __forceinline__ void stage_rc(int b, int& R, int& C) { const int st = b / 1024, sb = b % 1024, swz = sb ^ (((sb >> 9) & 1) << 5); R = (st >> 1) * 16 + swz / 64; C = (st & 1) * 32 + (swz % 64) / 2; }
__host__ __device__ __forceinline__ int perm32(int rho) { const int n = rho >> 4, i = rho & 15; return 8 * (i >> 2) + 4 * n + (i & 3); }

struct Unit { int pm, pn; };
struct Gemm { const bf16_t* A; const bf16_t* Bt; int M, N, K; };

struct StaticOrder {
    int nM, nN, nwg, G, c;
    __host__ __device__ void init(int M, int N, int G_, int c_) { nM = M / BM; nN = N / BM; nwg = nM * nN; G = G_; c = c_; }
    __host__ __device__ bool next(int i, Unit& u) const {
        const long L = (long)i * G + c; if (L >= nwg) return false;
        int wgid = (int)L; { const int q = nwg / NXCD, r = nwg % NXCD, xcd = wgid % NXCD, off = wgid / NXCD; wgid = (xcd < r ? xcd * (q + 1) : r * (q + 1) + (xcd - r) * q) + off; }
        const int nig = WGM * nN, gid = wgid / nig, fm = gid * WGM, gsz = (nM - fm) < WGM ? (nM - fm) : WGM;
        u.pm = fm + ((wgid % nig) % gsz); u.pn = (wgid % nig) / gsz; return true;
    }
    __device__ __forceinline__ void a_ready(const Unit&) const {}
    __device__ __forceinline__ void done(const Unit&) const {}
};

__device__ __forceinline__ unsigned cvt_pk_bf16(float lo, float hi) { unsigned r; asm volatile("v_cvt_pk_bf16_f32 %0, %1, %2" : "=v"(r) : "v"(lo), "v"(hi)); return r; }
typedef float f32x2 __attribute__((ext_vector_type(2)));

__device__ __forceinline__ u32x4 pk8(const f32x4& a, const f32x4& b) { u32x4 w; w.x = cvt_pk_bf16(a[0], a[1]); w.y = cvt_pk_bf16(a[2], a[3]); w.z = cvt_pk_bf16(b[0], b[1]); w.w = cvt_pk_bf16(b[2], b[3]); return w; }
__device__ __forceinline__ float fsig(float v) { return __builtin_amdgcn_rcpf(1.f + __builtin_amdgcn_exp2f(-1.4426950408889634f * v)); }
__device__ __forceinline__ f32x4 sig4(const f32x4& v) { return (f32x4){fsig(v[0]), fsig(v[1]), fsig(v[2]), fsig(v[3])}; }
__device__ __forceinline__ f32x4 silu4(const f32x4& v) { return v * sig4(v); }
struct EpiP1 {
    static constexpr bool PERM = true, AFTER_DRAIN = false;
    bf16_t *QA, *CKV, *KR, *ZS, *U, *T, *SG1, *SG2; float* ssq; const float2* rope;
    __device__ __forceinline__ void operator()(const f32x4 (&acc)[2][2][4][2], const Unit& u, int wr, int wc, int fr, int fq) const {
        const int pn = u.pn, row0 = u.pm * BM + wr * 64 + fr, cg = wc * 4 + fq;
        if (pn < 4) {
            bf16_t* dst = (pn < 2 ? QA : CKV) + (pn & 1) * 256 + 8 * cg; const int which = pn >> 1;
#pragma unroll
            for (int ai = 0; ai < 2; ++ai)
#pragma unroll
                for (int m = 0; m < 4; ++m) { const int row = row0 + ai * HALF + m * 16; float ss = 0.f;
#pragma unroll
                    for (int bj = 0; bj < 2; ++bj) { const f32x4 v0 = acc[ai][bj][m][0], v1 = acc[ai][bj][m][1];
                        *(u32x4*)(dst + (size_t)row * 512 + bj * HALF) = pk8(v0, v1);
                        ss += (v0[0] * v0[0] + v0[1] * v0[1]) + (v0[2] * v0[2] + v0[3] * v0[3]) + (v1[0] * v1[0] + v1[1] * v1[1]) + (v1[2] * v1[2] + v1[3] * v1[3]); }
                    ss += __shfl_xor(ss, 16); ss += __shfl_xor(ss, 32);
                    if (fq == 0) atomicAdd(ssq + row * 2 + which, ss); }
        } else if (pn == 4) {
            if (wc == 0) {
#pragma unroll
                for (int ai = 0; ai < 2; ++ai)
#pragma unroll
                    for (int m = 0; m < 4; ++m) { const int row = row0 + ai * HALF + m * 16; const f32x4* cs = (const f32x4*)(rope + (size_t)row * 32 + 8 * fq);
                        f32x4 o1[2], o2[2];
#pragma unroll
                        for (int n = 0; n < 2; ++n) { const f32x4 x1 = acc[ai][0][m][n], x2 = acc[ai][1][m][n]; const f32x4 c01 = cs[2 * n], c23 = cs[2 * n + 1];
                            o1[n] = (f32x4){x1[0] * c01[0] - x2[0] * c01[1], x1[1] * c01[2] - x2[1] * c01[3], x1[2] * c23[0] - x2[2] * c23[1], x1[3] * c23[2] - x2[3] * c23[3]};
                            o2[n] = (f32x4){x1[0] * c01[1] + x2[0] * c01[0], x1[1] * c01[3] + x2[1] * c01[2], x1[2] * c23[1] + x2[2] * c23[0], x1[3] * c23[3] + x2[3] * c23[2]}; }
                        *(u32x4*)(KR + (size_t)row * 64 + 8 * fq) = pk8(o1[0], o1[1]); *(u32x4*)(KR + (size_t)row * 64 + 32 + 8 * fq) = pk8(o2[0], o2[1]); }
            }
        } else if (pn < 13 || pn >= 45) {
            bf16_t* dst = (pn < 13 ? ZS + (pn - 5) * 256 : pn < 53 ? SG1 + (pn - 45) * 256 : SG2 + (pn - 53) * 256) + 8 * cg; const bool sl = pn < 13;
#pragma unroll
            for (int ai = 0; ai < 2; ++ai)
#pragma unroll
                for (int m = 0; m < 4; ++m) { const int row = row0 + ai * HALF + m * 16;
#pragma unroll
                    for (int bj = 0; bj < 2; ++bj) { f32x4 v0 = acc[ai][bj][m][0], v1 = acc[ai][bj][m][1];
                        if (sl) { v0 = silu4(v0); v1 = silu4(v1); } else { v0 = sig4(v0); v1 = sig4(v1); }
                        *(u32x4*)(dst + (size_t)row * 2048 + bj * HALF) = pk8(v0, v1); } }
        } else {
            const int ch0 = 64 * (pn - 13) + 4 * cg;
#pragma unroll
            for (int ai = 0; ai < 2; ++ai)
#pragma unroll
                for (int m = 0; m < 4; ++m) { const int row = row0 + ai * HALF + m * 16;
                    const f32x4 uu = acc[ai][1][m][0] * acc[ai][0][m][0], tt = acc[ai][0][m][1] * silu4(acc[ai][1][m][1]);
                    typedef unsigned u32x2v __attribute__((ext_vector_type(2)));
                    u32x2v wu, wt; wu.x = cvt_pk_bf16(uu[0], uu[1]); wu.y = cvt_pk_bf16(uu[2], uu[3]); wt.x = cvt_pk_bf16(tt[0], tt[1]); wt.y = cvt_pk_bf16(tt[2], tt[3]);
                    *(u32x2v*)(U + (size_t)row * 2048 + ch0) = wu; *(u32x2v*)(T + (size_t)row * 2048 + ch0) = wt; }
        }
    }
};
struct EpiQ {
    static constexpr bool PERM = true, AFTER_DRAIN = false;
    bf16_t *QN, *QR; const float* ssq; const float2* rope;
    __device__ __forceinline__ void operator()(const f32x4 (&acc)[2][2][4][2], const Unit& u, int wr, int wc, int fr, int fq) const {
        const int pn = u.pn, row0 = u.pm * BM + wr * 64 + fr, cg = wc * 4 + fq;
#pragma unroll
        for (int ai = 0; ai < 2; ++ai)
#pragma unroll
            for (int m = 0; m < 4; ++m) { const int row = row0 + ai * HALF + m * 16; const float rs = rsqrtf(ssq[row * 2] * (1.f / 512.f) + 1e-6f) * (0.07216878364870322f * 1.4426950408889634f);
                if (pn < 8) {
#pragma unroll
                    for (int bj = 0; bj < 2; ++bj) *(u32x4*)(QN + (size_t)row * 2048 + pn * 256 + bj * HALF + 8 * cg) = pk8(acc[ai][bj][m][0] * rs, acc[ai][bj][m][1] * rs);
                } else { const int head = 4 * (pn - 8) + wc; const f32x4* cs = (const f32x4*)(rope + (size_t)row * 32 + 8 * fq); f32x4 o1[2], o2[2];
#pragma unroll
                    for (int n = 0; n < 2; ++n) { const f32x4 x1 = acc[ai][0][m][n] * rs, x2 = acc[ai][1][m][n] * rs; const f32x4 c01 = cs[2 * n], c23 = cs[2 * n + 1];
                        o1[n] = (f32x4){x1[0] * c01[0] - x2[0] * c01[1], x1[1] * c01[2] - x2[1] * c01[3], x1[2] * c23[0] - x2[2] * c23[1], x1[3] * c23[2] - x2[3] * c23[3]};
                        o2[n] = (f32x4){x1[0] * c01[1] + x2[0] * c01[0], x1[1] * c01[3] + x2[1] * c01[2], x1[2] * c23[1] + x2[2] * c23[0], x1[3] * c23[3] + x2[3] * c23[2]}; }
                    *(u32x4*)(QR + (size_t)row * 1024 + 64 * head + 8 * fq) = pk8(o1[0], o1[1]); *(u32x4*)(QR + (size_t)row * 1024 + 64 * head + 32 + 8 * fq) = pk8(o2[0], o2[1]); }
            }
    }
};
struct EpiKV {
    static constexpr bool PERM = true, AFTER_DRAIN = false;
    bf16_t *KN, *V; const float* ssq;
    __device__ __forceinline__ void operator()(const f32x4 (&acc)[2][2][4][2], const Unit& u, int wr, int wc, int fr, int fq) const {
        const int pn = u.pn, row0 = u.pm * BM + wr * 64 + fr, cg = wc * 4 + fq; bf16_t* dst = (pn < 8 ? KN + pn * 256 : V + (pn - 8) * 256) + 8 * cg;
#pragma unroll
        for (int ai = 0; ai < 2; ++ai)
#pragma unroll
            for (int m = 0; m < 4; ++m) { const int row = row0 + ai * HALF + m * 16; const float rs = rsqrtf(ssq[row * 2 + 1] * (1.f / 512.f) + 1e-6f);
#pragma unroll
                for (int bj = 0; bj < 2; ++bj) *(u32x4*)(dst + (size_t)row * 2048 + bj * HALF) = pk8(acc[ai][bj][m][0] * rs, acc[ai][bj][m][1] * rs); }
    }
};
__device__ __forceinline__ void unpk8(const u32x4& w, f32x4& a, f32x4& b) {
    a = (f32x4){__uint_as_float(w.x << 16), __uint_as_float(w.x & 0xffff0000u), __uint_as_float(w.y << 16), __uint_as_float(w.y & 0xffff0000u)};
    b = (f32x4){__uint_as_float(w.z << 16), __uint_as_float(w.z & 0xffff0000u), __uint_as_float(w.w << 16), __uint_as_float(w.w & 0xffff0000u)}; }
struct EpiY1 {
    static constexpr bool PERM = true, AFTER_DRAIN = false;
    float* tmpf; const bf16_t* sg;
    __device__ __forceinline__ void operator()(const f32x4 (&acc)[2][2][4][2], const Unit& u, int wr, int wc, int fr, int fq) const {
        const int row0 = u.pm * BM + wr * 64 + fr, col0 = u.pn * BM + 8 * (wc * 4 + fq);
#pragma unroll
        for (int ai = 0; ai < 2; ++ai)
#pragma unroll
            for (int m = 0; m < 4; ++m) { const size_t ro = (size_t)(row0 + ai * HALF + m * 16) * 2048 + col0;
#pragma unroll
                for (int bj = 0; bj < 2; ++bj) { f32x4 g0, g1; unpk8(*(const u32x4*)(sg + ro + bj * HALF), g0, g1);
                    *(f32x4*)(tmpf + ro + bj * HALF) = acc[ai][bj][m][0] * g0; *(f32x4*)(tmpf + ro + bj * HALF + 4) = acc[ai][bj][m][1] * g1; } }
    }
};
struct EpiY2 {
    static constexpr bool PERM = true, AFTER_DRAIN = false;
    const float* tmpf; const bf16_t* sg; bf16_t* mg;
    __device__ __forceinline__ void operator()(const f32x4 (&acc)[2][2][4][2], const Unit& u, int wr, int wc, int fr, int fq) const {
        const int row0 = u.pm * BM + wr * 64 + fr, col0 = u.pn * BM + 8 * (wc * 4 + fq);
#pragma unroll
        for (int ai = 0; ai < 2; ++ai)
#pragma unroll
            for (int m = 0; m < 4; ++m) { const size_t ro = (size_t)(row0 + ai * HALF + m * 16) * 2048 + col0;
#pragma unroll
                for (int bj = 0; bj < 2; ++bj) { f32x4 g0, g1; unpk8(*(const u32x4*)(sg + ro + bj * HALF), g0, g1);
                    const f32x4 t0 = *(const f32x4*)(tmpf + ro + bj * HALF), t1 = *(const f32x4*)(tmpf + ro + bj * HALF + 4);
                    *(u32x4*)(mg + ro + bj * HALF) = pk8(t0 + acc[ai][bj][m][0] * g0, t1 + acc[ai][bj][m][1] * g1); } }
    }
};
struct EpiOut {
    static constexpr bool PERM = true, AFTER_DRAIN = false;
    float* outf;
    __device__ __forceinline__ void operator()(const f32x4 (&acc)[2][2][4][2], const Unit& u, int wr, int wc, int fr, int fq) const {
        const int row0 = u.pm * BM + wr * 64 + fr, col0 = u.pn * BM + 8 * (wc * 4 + fq);
#pragma unroll
        for (int ai = 0; ai < 2; ++ai)
#pragma unroll
            for (int m = 0; m < 4; ++m) { const size_t ro = (size_t)(row0 + ai * HALF + m * 16) * 2048 + col0;
#pragma unroll
                for (int bj = 0; bj < 2; ++bj) { *(f32x4*)(outf + ro + bj * HALF) = acc[ai][bj][m][0]; *(f32x4*)(outf + ro + bj * HALF + 4) = acc[ai][bj][m][1]; } }
    }
};

template <class Epi, class Sched, bool ALIGN_EPI = false, bool SP2 = false>
__device__ __forceinline__ void gemm_phase(PG8_LAS unsigned char* lds, const Gemm g, const Sched& S, const Epi& E) {
    const int tid = threadIdx.x, wid = __builtin_amdgcn_readfirstlane(tid >> 6), lane = tid & 63, wr = wid >> 2, wc = wid & 3, fr = lane & 15, fq = lane >> 4;
    const int K = g.K, nt = K / BK;
    unsigned voffA[2], voffB[2];
#pragma unroll
    for (int i = 0; i < 2; ++i) { int R, C; stage_rc(tid * 16 + i * 8192, R, C); const int Rb = Epi::PERM ? ((R & ~31) + perm32(R & 31)) : R;
        voffA[i] = (unsigned)(R * K + C) * 2u; voffB[i] = (unsigned)(Rb * K + C) * 2u; }
    const size_t kstep = (size_t)(BK * 2);
    const size_t hstep = (size_t)HALF * K * 2;
    const size_t tstep = 2 * hstep;
    const unsigned ldsw = (unsigned)wid * 1024u;
    const int aoff = lds_byte(wr * 64 + fr, fq * 8), boff = lds_byte(wc * 32 + fr, fq * 8);
#define PG8_SA(b, h) (((b) * 2 + (h)) * HTB)
#define PG8_SB(b, h) ((4 + (b) * 2 + (h)) * HTB)
#define PG8_STAGE(bufoff, gbase, voff) do { _Pragma("unroll") for (int _i = 0; _i < 2; ++_i) \
        __builtin_amdgcn_global_load_lds((const unsigned*)((const char*)(gbase) + (voff)[_i]), (PG8_LAS unsigned*)(lds + (bufoff) + ldsw + _i * 8192), 16, 0, 0); } while (0)
#define PG8_LDA(dst, b, h) do { _Pragma("unroll") for (int m = 0; m < 4; ++m) _Pragma("unroll") for (int k = 0; k < 2; ++k) dst[m][k] = *(const PG8_LAS bf16x8*)(lds + PG8_SA(b, h) + aoff + m * 2048 + k * 1024); } while (0)
#define PG8_LDB(dst, b, h) do { _Pragma("unroll") for (int n = 0; n < 2; ++n) _Pragma("unroll") for (int k = 0; k < 2; ++k) dst[n][k] = *(const PG8_LAS bf16x8*)(lds + PG8_SB(b, h) + boff + n * 2048 + k * 1024); } while (0)
#define PG8_MMA(ai, bj, At, Bt) do { __builtin_amdgcn_s_setprio(1); _Pragma("unroll") for (int m = 0; m < 4; ++m) _Pragma("unroll") for (int n = 0; n < 2; ++n) _Pragma("unroll") for (int k = 0; k < 2; ++k) \
        acc[ai][bj][m][n] = __builtin_amdgcn_mfma_f32_16x16x32_bf16(Bt[n][k], At[m][k], acc[ai][bj][m][n], 0, 0, 0); __builtin_amdgcn_s_setprio(0); } while (0)
#define PG8_WAIT_V(n) asm volatile("s_waitcnt vmcnt(" #n ")" ::: "memory")
#define PG8_WAIT_L(n) asm volatile("s_waitcnt lgkmcnt(" #n ")" ::: "memory")
#define PG8_BAR __builtin_amdgcn_s_barrier()
#define PG8_SCHED __builtin_amdgcn_sched_barrier(0)
    Unit cur, nxt; int ui = 0;
    if (!S.next(0, cur)) return;
    f32x4 acc[2][2][4][2];
#pragma unroll
    for (int a = 0; a < 2; ++a)
#pragma unroll
        for (int b = 0; b < 2; ++b)
#pragma unroll
            for (int m = 0; m < 4; ++m)
#pragma unroll
                for (int n = 0; n < 2; ++n) acc[a][b][m][n] = (f32x4){0.f, 0.f, 0.f, 0.f};
    bf16x8 At[4][2], B0[2][2], B1[2][2];
    const char* cA = (const char*)g.A + (size_t)cur.pm * tstep; const char* cB = (const char*)g.Bt + (size_t)cur.pn * tstep;
    S.a_ready(cur);
    if constexpr (SP2) {
        PG8_STAGE(PG8_SB(0, 0), cB, voffB); PG8_STAGE(PG8_SB(0, 1), cB + hstep, voffB); PG8_STAGE(PG8_SA(0, 0), cA, voffA); PG8_STAGE(PG8_SA(0, 1), cA + hstep, voffA);
        if (wr == 1) PG8_BAR;
        PG8_WAIT_V(2); PG8_BAR;
        PG8_STAGE(PG8_SB(1, 0), cB + kstep, voffB); PG8_STAGE(PG8_SA(1, 0), cA + kstep, voffA); PG8_STAGE(PG8_SB(1, 1), cB + hstep + kstep, voffB);
        PG8_WAIT_V(6); PG8_BAR;
    } else {
        PG8_STAGE(PG8_SB(0, 0), cB, voffB); PG8_STAGE(PG8_SA(0, 0), cA, voffA); PG8_STAGE(PG8_SB(0, 1), cB + hstep, voffB); PG8_STAGE(PG8_SA(0, 1), cA + hstep, voffA);
        if (wr == 1) PG8_BAR;
        PG8_WAIT_V(4); PG8_BAR;
        PG8_STAGE(PG8_SB(1, 0), cB + kstep, voffB); PG8_STAGE(PG8_SA(1, 0), cA + kstep, voffA); PG8_STAGE(PG8_SB(1, 1), cB + hstep + kstep, voffB);
        PG8_WAIT_V(6); PG8_BAR;
    }
    for (;;) {
        const bool has_next = S.next(ui + 1, nxt);
        const char* nA = has_next ? (const char*)g.A + (size_t)nxt.pm * tstep : cA; const char* nB = has_next ? (const char*)g.Bt + (size_t)nxt.pn * tstep : cB;
        for (int t = 0; t < nt; t += 2) {
            const bool last = (t == nt - 2);
            const char* a1 = cA + (size_t)(t + 1) * kstep;
            const char* a2 = last ? nA : cA + (size_t)(t + 2) * kstep; const char* b2 = last ? nB : cB + (size_t)(t + 2) * kstep;
            const char* a3 = a2 + kstep; const char* b3 = b2 + kstep;
            if (last && has_next) S.a_ready(nxt);
            if constexpr (SP2) {
            PG8_LDB(B0, 0, 0); PG8_LDB(B1, 0, 1); PG8_SCHED; PG8_LDA(At, 0, 0); PG8_STAGE(PG8_SA(1, 1), a1 + hstep, voffA);
            PG8_WAIT_V(8); PG8_WAIT_L(0); PG8_BAR; PG8_MMA(0, 0, At, B0); PG8_MMA(0, 1, At, B1); PG8_BAR; PG8_SCHED;
            PG8_LDA(At, 0, 1); PG8_STAGE(PG8_SB(0, 0), b2, voffB); PG8_STAGE(PG8_SB(0, 1), b2 + hstep, voffB); PG8_STAGE(PG8_SA(0, 0), a2, voffA);
            PG8_WAIT_V(8); PG8_WAIT_L(0); PG8_BAR; PG8_MMA(1, 0, At, B0); PG8_MMA(1, 1, At, B1); PG8_BAR; PG8_SCHED;
            PG8_LDB(B0, 1, 0); PG8_LDB(B1, 1, 1); PG8_SCHED; PG8_LDA(At, 1, 0); PG8_STAGE(PG8_SA(0, 1), a2 + hstep, voffA);
            PG8_WAIT_V(8); PG8_WAIT_L(0); PG8_BAR; PG8_MMA(0, 0, At, B0); PG8_MMA(0, 1, At, B1); PG8_BAR; PG8_SCHED;
            PG8_LDA(At, 1, 1); PG8_STAGE(PG8_SB(1, 0), b3, voffB); PG8_STAGE(PG8_SB(1, 1), b3 + hstep, voffB); PG8_STAGE(PG8_SA(1, 0), a3, voffA);
            PG8_WAIT_V(8); PG8_WAIT_L(0); PG8_BAR; PG8_MMA(1, 0, At, B0); PG8_MMA(1, 1, At, B1); PG8_BAR; PG8_SCHED;
            } else {
            PG8_LDB(B0, 0, 0); PG8_SCHED; PG8_LDA(At, 0, 0); PG8_STAGE(PG8_SA(1, 1), a1 + hstep, voffA);
            PG8_WAIT_L(8); PG8_BAR; PG8_WAIT_L(0); PG8_MMA(0, 0, At, B0); PG8_BAR; PG8_SCHED;
            PG8_LDB(B1, 0, 1); PG8_STAGE(PG8_SB(0, 0), b2, voffB);
            PG8_BAR; PG8_WAIT_L(0); PG8_MMA(0, 1, At, B1); PG8_BAR;
            PG8_LDA(At, 0, 1); PG8_STAGE(PG8_SA(0, 0), a2, voffA);
            PG8_BAR; PG8_WAIT_L(0); PG8_MMA(1, 0, At, B0); PG8_BAR; PG8_SCHED;
            PG8_STAGE(PG8_SB(0, 1), b2 + hstep, voffB);
            PG8_WAIT_V(6); PG8_BAR; PG8_MMA(1, 1, At, B1); PG8_BAR;
            PG8_LDB(B0, 1, 0); PG8_SCHED; PG8_LDA(At, 1, 0); PG8_STAGE(PG8_SA(0, 1), a2 + hstep, voffA);
            PG8_WAIT_L(8); PG8_BAR; PG8_WAIT_L(0); PG8_MMA(0, 0, At, B0); PG8_BAR; PG8_SCHED;
            PG8_LDB(B1, 1, 1); PG8_STAGE(PG8_SB(1, 0), b3, voffB);
            PG8_BAR; PG8_WAIT_L(0); PG8_MMA(0, 1, At, B1); PG8_BAR;
            PG8_LDA(At, 1, 1); PG8_STAGE(PG8_SA(1, 0), a3, voffA);
            PG8_BAR; PG8_WAIT_L(0); PG8_MMA(1, 0, At, B0); PG8_BAR; PG8_SCHED;
            PG8_STAGE(PG8_SB(1, 1), b3 + hstep, voffB);
            PG8_WAIT_V(6); PG8_BAR; PG8_MMA(1, 1, At, B1); PG8_BAR;
            }
        }
        if constexpr (ALIGN_EPI) { if (wr == 0) PG8_BAR; }
        if constexpr (!Epi::AFTER_DRAIN) { E(acc, cur, wr, wc, fr, fq); S.done(cur); }
        if (!has_next) break;
#pragma unroll
        for (int a = 0; a < 2; ++a)
#pragma unroll
            for (int b = 0; b < 2; ++b)
#pragma unroll
                for (int m = 0; m < 4; ++m)
#pragma unroll
                    for (int n = 0; n < 2; ++n) acc[a][b][m][n] = (f32x4){0.f, 0.f, 0.f, 0.f};
        cur = nxt; cA = nA; cB = nB; ++ui;
        if constexpr (ALIGN_EPI) { if (wr == 1) PG8_BAR; }
    }
    PG8_WAIT_V(0);
    if constexpr (!ALIGN_EPI) { if (wr == 0) PG8_BAR; }
    PG8_BAR;
    if constexpr (Epi::AFTER_DRAIN) { E.fused(acc, cur, wr, wc, fr, fq, lds, wid, lane); S.done(cur); }
#undef PG8_SA
#undef PG8_SB
#undef PG8_STAGE
#undef PG8_LDA
#undef PG8_LDB
#undef PG8_MMA
#undef PG8_WAIT_V
#undef PG8_WAIT_L
#undef PG8_BAR
#undef PG8_SCHED
}
}

namespace att {
typedef short bf16x8 __attribute__((ext_vector_type(8)));
typedef short s16x4 __attribute__((ext_vector_type(4)));
typedef float f32x16 __attribute__((ext_vector_type(16)));
typedef float f32x4 __attribute__((ext_vector_type(4)));
typedef unsigned u32x4 __attribute__((ext_vector_type(4)));
constexpr int NW = 8, QBLK = 32, KVBLK = 64, QB = NW * QBLK, NQB = S / QB;
constexpr int SHM_V = KVBLK * 128 * 2, SHM_KN = KVBLK * 128 * 2, SHM_KR = KVBLK * 64 * 2;
constexpr int OFF_V = 0, OFF_KN = 2 * SHM_V, OFF_KR = OFF_KN + 2 * SHM_KN, OFF_WS = OFF_KR + 2 * SHM_KR, OFF_QR = OFF_WS + NW * 64 * 4, LDS_BYTES = OFF_QR + NW * 4096;
constexpr float THR2 = 8.f * 1.4426950408889634f;
#define KSWZ(row, colB) ((row) * 256 + ((colB) ^ (((row) & 7) << 4)))
#define SBAR() __builtin_amdgcn_sched_barrier(0)
__device__ __forceinline__ int kr_off(int row, int ch8) { return (ch8 >> 2) * 4096 + row * 64 + (((ch8 & 3) ^ ((row >> 2) & 3)) << 4); }
__device__ __forceinline__ int v_st(int k, int c) { const int kk = (k & ~0xC) | ((k & 4) << 1) | ((k & 8) >> 1); return ((kk >> 3) * 4 + (c >> 5)) * 512 + ((kk & 7) * 32 + (c & 31)) * 2; }
__device__ __forceinline__ int v_rd_base(int lane) { return ((lane & 3) << 3) | (((lane >> 2) & 3) << 6) | (((lane >> 4) & 1) << 5) | (((lane >> 5) & 1) << 8); }
constexpr int v_rd_off(int d0, int ks, int half) { return d0 * 512 + ks * 4096 + half * 2048; }
__device__ __forceinline__ int crow(int r, int hi) { return (r & 3) + 8 * (r >> 2) + 4 * hi; }
__device__ __forceinline__ unsigned cvtpk(float lo, float hi) { unsigned r; asm volatile("v_cvt_pk_bf16_f32 %0, %1, %2" : "=v"(r) : "v"(lo), "v"(hi)); return r; }
__device__ __forceinline__ void mask_tile(f32x16& p0, f32x16& p1, int dq) {
    const float NEG = -__builtin_inff();
#pragma unroll
    for (int r = 0; r < 16; ++r) { const int c = (r & 3) + 8 * (r >> 2);
        if (dq - c < 0) p0[r] = NEG;
        if (dq - c - 32 < 0) p1[r] = NEG; }
}
__device__ __forceinline__ void partialSM(f32x16& p0, f32x16& p1, float& m_reg, float& mn, float& alpha) {
    float pmax = p0[0];
#pragma unroll
    for (int r = 1; r < 16; ++r) pmax = fmaxf(pmax, p0[r]);
#pragma unroll
    for (int r = 0; r < 16; ++r) pmax = fmaxf(pmax, p1[r]);
    { auto rr = __builtin_amdgcn_permlane32_swap(__float_as_uint(pmax), __float_as_uint(pmax), false, false);
      pmax = fmaxf(__uint_as_float(rr[0]), __uint_as_float(rr[1])); }
    if (__builtin_expect(__all((pmax - m_reg) <= THR2), 1)) { mn = m_reg; alpha = 1.f; }
    else { mn = fmaxf(m_reg, pmax); alpha = __builtin_amdgcn_exp2f(m_reg - mn); m_reg = mn; }
#pragma unroll
    for (int r = 0; r < 16; ++r) p0[r] = p0[r] - mn;
#pragma unroll
    for (int r = 0; r < 16; ++r) p1[r] = p1[r] - mn;
#pragma unroll
    for (int r = 0; r < 16; ++r) p0[r] = __builtin_amdgcn_exp2f(p0[r]);
}
__device__ __forceinline__ void finishSM(f32x16& p0, f32x16& p1, float alpha, float& l_reg, bf16x8& pa0, bf16x8& pa1, bf16x8& pa2, bf16x8& pa3) {
#pragma unroll
    for (int r = 0; r < 16; ++r) p1[r] = __builtin_amdgcn_exp2f(p1[r]);
    float ps = 0;
#pragma unroll
    for (int r = 0; r < 16; ++r) ps += p0[r];
#pragma unroll
    for (int r = 0; r < 16; ++r) ps += p1[r];
    { auto rr = __builtin_amdgcn_permlane32_swap(__float_as_uint(ps), __float_as_uint(ps), false, false);
      ps = __uint_as_float(rr[0]) + __uint_as_float(rr[1]); }
    l_reg = l_reg * alpha + ps;
#define PK4(P, B_, OUT) do { unsigned a0 = cvtpk(P[B_+0], P[B_+1]), a1 = cvtpk(P[B_+2], P[B_+3]);                          \
        unsigned b0 = cvtpk(P[B_+4], P[B_+5]), b1 = cvtpk(P[B_+6], P[B_+7]);                                             \
        auto r0 = __builtin_amdgcn_permlane32_swap(a0, b0, false, false); auto r1 = __builtin_amdgcn_permlane32_swap(a1, b1, false, false); \
        u32x4 w = {r0[0], r1[0], r0[1], r1[1]}; OUT = *reinterpret_cast<bf16x8*>(&w); } while (0)
    PK4(p0, 0, pa0); PK4(p0, 8, pa1); PK4(p1, 0, pa2); PK4(p1, 8, pa3);
#undef PK4
}
template <int KB>
__device__ __forceinline__ void qkt(f32x16& p0, f32x16& p1, const char* lds, int r32, int hi, const bf16x8* qr, const char* ql0, const char* ql1) {
    p0 = f32x16{}; p1 = f32x16{};
    const char* kb[4];
#pragma unroll
    for (int dd = 0; dd < 4; ++dd) kb[dd] = lds + OFF_KN + KB * SHM_KN + KSWZ(r32, (dd * 16 + hi * 8) * 2);
#pragma unroll
    for (int d0 = 0; d0 < 8; ++d0) { const char* a = kb[d0 & 3] + (d0 >> 2) * 128;
        bf16x8 b0 = *reinterpret_cast<const bf16x8*>(a);
        bf16x8 b1 = *reinterpret_cast<const bf16x8*>(a + 32 * 256);
        p0 = __builtin_amdgcn_mfma_f32_32x32x16_bf16(b0, qr[d0], p0, 0, 0, 0);
        p1 = __builtin_amdgcn_mfma_f32_32x32x16_bf16(b1, qr[d0], p1, 0, 0, 0); }
    const char* kr[2];
#pragma unroll
    for (int e = 0; e < 2; ++e) kr[e] = lds + OFF_KR + KB * SHM_KR + kr_off(r32, 2 * e + hi);
#pragma unroll
    for (int d0 = 0; d0 < 4; ++d0) { const char* a = kr[d0 & 1] + (d0 >> 1) * 4096;
        bf16x8 b0 = *reinterpret_cast<const bf16x8*>(a);
        bf16x8 b1 = *reinterpret_cast<const bf16x8*>(a + 32 * 64);
        const bf16x8 qf = *reinterpret_cast<const bf16x8*>(((d0 & 1) ? ql1 : ql0) + (d0 >> 1) * 2048);
        p0 = __builtin_amdgcn_mfma_f32_32x32x16_bf16(b0, qf, p0, 0, 0, 0);
        p1 = __builtin_amdgcn_mfma_f32_32x32x16_bf16(b1, qf, p1, 0, 0, 0); }
}
template <int VB>
__device__ __forceinline__ void pv_tile(f32x16* o, int vb0, bf16x8 pa0, bf16x8 pa1, bf16x8 pa2, bf16x8 pa3) {
#define TRRD(dst, off) asm volatile("ds_read_b64_tr_b16 %0, %1 offset:%2" : "=&v"(dst) : "v"(vb0), "i"(off) : "memory")
#define PV_D0(d0) do { s16x4 l0, l1, l2, l3, h0, h1, h2, h3; constexpr int b_ = OFF_V + VB * SHM_V + v_rd_off(d0, 0, 0);     \
        TRRD(l0, b_); TRRD(h0, b_ + 2048); TRRD(l1, b_ + 4096); TRRD(h1, b_ + 6144); TRRD(l2, b_ + 8192); TRRD(h2, b_ + 10240); TRRD(l3, b_ + 12288); TRRD(h3, b_ + 14336); \
        asm volatile("s_waitcnt lgkmcnt(0)" ::: "memory"); SBAR();   \
        o[d0] = __builtin_amdgcn_mfma_f32_32x32x16_bf16(pa0, (bf16x8){l0[0], l0[1], l0[2], l0[3], h0[0], h0[1], h0[2], h0[3]}, o[d0], 0, 0, 0);   \
        o[d0] = __builtin_amdgcn_mfma_f32_32x32x16_bf16(pa1, (bf16x8){l1[0], l1[1], l1[2], l1[3], h1[0], h1[1], h1[2], h1[3]}, o[d0], 0, 0, 0);   \
        o[d0] = __builtin_amdgcn_mfma_f32_32x32x16_bf16(pa2, (bf16x8){l2[0], l2[1], l2[2], l2[3], h2[0], h2[1], h2[2], h2[3]}, o[d0], 0, 0, 0);   \
        o[d0] = __builtin_amdgcn_mfma_f32_32x32x16_bf16(pa3, (bf16x8){l3[0], l3[1], l3[2], l3[3], h3[0], h3[1], h3[2], h3[3]}, o[d0], 0, 0, 0); } while (0)
    PV_D0(0); PV_D0(1); PV_D0(2); PV_D0(3);
#undef PV_D0
#undef TRRD
}
struct Tens { const bf16_t *QN, *QR, *KN, *KR, *V, *ZS; bf16_t* AO; };
struct BlockRef { int h, P0; };
struct Stage { bf16x8 st_v0, st_v1, st_k0, st_k1, st_kr; };
#define VMW() asm volatile("s_waitcnt vmcnt(0)" ::: "memory")
#define LD8(p) (*reinterpret_cast<const bf16x8*>(p))
#define SLOAD_H(hh, k0) do { const bf16_t* vp_ = T.V + (size_t)((k0) + sr) * 2048 + (hh) * 128 + sc; const bf16_t* kp_ = T.KN + (size_t)((k0) + sr) * 2048 + (hh) * 128 + sc;   \
        G.st_v0 = LD8(vp_); G.st_v1 = LD8(vp_ + 32 * 2048); G.st_k0 = LD8(kp_); G.st_k1 = LD8(kp_ + 32 * 2048); G.st_kr = LD8(T.KR + (size_t)((k0) + krow) * 64 + kch * 8); } while (0)
#define SWRITE_H(bf) do { *(bf16x8*)(lds + OFF_V + (bf) * SHM_V + vst0) = G.st_v0; *(bf16x8*)(lds + OFF_V + (bf) * SHM_V + vst1) = G.st_v1;                          \
        *(bf16x8*)(lds + OFF_KN + (bf) * SHM_KN + kws) = G.st_k0; *(bf16x8*)(lds + OFF_KN + (bf) * SHM_KN + kws + 32 * 256) = G.st_k1; *(bf16x8*)(lds + OFF_KR + (bf) * SHM_KR + krws) = G.st_kr; } while (0)
__device__ __forceinline__ void softmax_tile(f32x16& p0, f32x16& p1, float& m_reg, float& l_reg, float& alpha, bf16x8& pa0, bf16x8& pa1, bf16x8& pa2, bf16x8& pa3) {
    float mn; partialSM(p0, p1, m_reg, mn, alpha);
    finishSM(p0, p1, alpha, l_reg, pa0, pa1, pa2, pa3);
}
__device__ __forceinline__ void attn_block(const Tens& T, const BlockRef& cur, char* lds) {
    const int tid = threadIdx.x, wid = __builtin_amdgcn_readfirstlane(tid >> 6), lane = tid & 63, r32 = lane & 31, hi = lane >> 5;
    const int NT = (cur.P0 + QB) / KVBLK;
    const int qlo = cur.P0 + wid * QBLK, qm = qlo + r32 - 4 * hi;
    float* ws = (float*)(lds + OFF_WS) + wid * 64; float* li_l = ws, * al_l = ws + 32;
    float m_reg = -1e30f, l_reg = 0; f32x16 o[4] = {};
    const int sr = tid >> 4, sc = (tid & 15) * 8, vst0 = v_st(sr, sc), vst1 = v_st(32 + sr, sc), kws = KSWZ(sr, sc * 2), krow = tid >> 3, kch = tid & 7, krws = kr_off(krow, kch);
    const int vb0 = (int)(uintptr_t)(lds) + v_rd_base(lane);
    const int hh = cur.h;
    Stage G; bf16x8 qr[8];
    char* const ql0 = lds + OFF_QR + wid * 4096 + r32 * 64 + (((hi) ^ ((r32 >> 2) & 3)) << 4); char* const ql1 = lds + OFF_QR + wid * 4096 + r32 * 64 + (((2 + hi) ^ ((r32 >> 2) & 3)) << 4);
    SLOAD_H(hh, 0);
    { const size_t qrow_ = (size_t)(cur.P0 + wid * QBLK + r32);
#pragma unroll
      for (int d0 = 0; d0 < 8; ++d0) qr[d0] = LD8(T.QN + qrow_ * 2048 + hh * 128 + d0 * 16 + hi * 8);
      const bf16_t* qp_ = T.QR + qrow_ * 1024 + hh * 64 + hi * 8;
      const bf16x8 t0 = LD8(qp_), t1 = LD8(qp_ + 16), t2 = LD8(qp_ + 32), t3 = LD8(qp_ + 48);
      *(bf16x8*)(ql0) = t0; *(bf16x8*)(ql1) = t1; *(bf16x8*)(ql0 + 2048) = t2; *(bf16x8*)(ql1 + 2048) = t3; }
    VMW(); SWRITE_H(0);
    SLOAD_H(hh, KVBLK);
    f32x16 p0, p1; float alpha; bf16x8 pa0, pa1, pa2, pa3;
#define TILE(t, BF) do {                                                                                                      \
        __syncthreads();                                        \
        if ((t) + 1 < NT) { VMW(); SWRITE_H((BF) ^ 1); }                                                                     \
        if ((t) + 2 < NT) { SLOAD_H(hh, ((t) + 2) * KVBLK); }                                                                \
        SBAR(); qkt<BF>(p0, p1, lds, r32, hi, qr, ql0, ql1);                                                                  \
        { const int kb_ = (t) * KVBLK; if (kb_ + KVBLK - 1 > qlo) mask_tile(p0, p1, qm - kb_); }                              \
        softmax_tile(p0, p1, m_reg, l_reg, alpha, pa0, pa1, pa2, pa3);                                                        \
        if (__any(alpha < 1.f)) { if (hi == 0) al_l[r32] = alpha; asm volatile("s_waitcnt lgkmcnt(0)" ::: "memory");          \
            _Pragma("unroll") for (int d_ = 0; d_ < 4; ++d_) _Pragma("unroll") for (int r = 0; r < 16; ++r) o[d_][r] *= al_l[crow(r, hi)]; }   \
        SBAR(); pv_tile<BF>(o, vb0, pa0, pa1, pa2, pa3); } while (0)
    for (int t = 0; t < NT; t += 2) { TILE(t, 0); TILE(t + 1, 1); }
#undef TILE
    if (hi == 0) li_l[r32] = l_reg; asm volatile("s_waitcnt lgkmcnt(0)" ::: "memory");
    float rli[16];
#pragma unroll
    for (int r = 0; r < 16; ++r) rli[r] = __builtin_amdgcn_rcpf(li_l[crow(r, hi)]);
    const size_t ob = (size_t)(cur.P0 + wid * QBLK) * 2048 + hh * 128;
#pragma unroll
    for (int r = 0; r < 16; ++r) { const int orow = crow(r, hi);
#pragma unroll
        for (int d0 = 0; d0 < 4; ++d0) { const size_t idx = ob + (size_t)orow * 2048 + d0 * 32 + r32;
            const float v = o[d0][r] * rli[r] * bf2f(T.ZS[idx]);
            const float vn = __shfl_xor(v, 1);
            if ((r32 & 1) == 0) *(unsigned*)(T.AO + idx) = cvtpk(v, vn); } }
    __syncthreads();
}
__device__ __forceinline__ BlockRef item_ref(int L, int pass) { const int xc = L & 7, k = L >> 3; BlockRef r; r.h = 2 * xc + (k >> 4); const int x = k & 15; r.P0 = (pass ? 31 - x : x) * QB; return r; }
__device__ __forceinline__ void attn_phase(const Tens& T, char* lds) {
    for (int L = blockIdx.x; L < NH * 16; L += gridDim.x)
        for (int pass = 0; pass < 2; ++pass) attn_block(T, item_ref(L, pass), lds);
}
#undef VMW
#undef LD8
#undef SLOAD_H
#undef SWRITE_H
#undef KSWZ
#undef SBAR
}

#define XB_TMO      128
#define XB_XCNT(j)  (256  + 64 * (j))
#define XB_XSUB(j)  (1280 + 64 * (j))
#define XB_XGEN(j)  (2304 + 64 * (j))
#define XB_TOP      3328
#define XB_TOPGEN   3392
#define XCD_BAR_WORDS 3456
#define XB_SPIN_CAP (1u << 18)

__device__ __forceinline__ unsigned xb_ld(unsigned* p)              { return __hip_atomic_load(p, __ATOMIC_RELAXED, __HIP_MEMORY_SCOPE_AGENT); }
__device__ __forceinline__ unsigned xb_add(unsigned* p, unsigned v) { return __hip_atomic_fetch_add(p, v, __ATOMIC_RELAXED, __HIP_MEMORY_SCOPE_AGENT); }
__device__ __forceinline__ unsigned xb_xcc_id() { return (unsigned)__builtin_amdgcn_s_getreg((3 << 11) | 20) & 0xFu; }
#define XB_SPIN(cond, bar) do { unsigned _sp = 0; while (cond) { __builtin_amdgcn_s_sleep(1); \
    if ((++_sp & 255u) == 0u) { if (xb_ld(&(bar)[XB_TMO])) break; if (_sp > XB_SPIN_CAP) { atomicAdd(&(bar)[XB_TMO], 1u); break; } } } } while (0)

struct XcdBarrier {
    unsigned* bar; unsigned x;
    volatile LAS unsigned* st;
};

__device__ __forceinline__ XcdBarrier xcd_barrier_post(unsigned* bar, volatile LAS unsigned* st) {
    XcdBarrier b; b.bar = bar; b.x = xb_xcc_id(); b.st = st;
    if (threadIdx.x == 0) (void)xb_add(&bar[XB_XCNT(b.x)], 1u);
    return b;
}
__device__ __forceinline__ void xcd_barrier_complete(unsigned* bar, unsigned x, unsigned& nloc, unsigned& nx) {
    const unsigned G = gridDim.x * gridDim.y * gridDim.z;
    unsigned sum, cnt, mine, sp = 0u;
    for (;;) {
        sum = 0u; cnt = 0u; mine = 0u;
#pragma unroll
        for (unsigned j = 0; j < 16; ++j) { const unsigned c = xb_ld(&bar[XB_XCNT(j)]); sum += c; cnt += (c > 0u) ? 1u : 0u; mine = (j == x) ? c : mine; }
        if (sum == G) break;
        __builtin_amdgcn_s_sleep(1);
        if ((++sp & 255u) == 0u) { if (xb_ld(&bar[XB_TMO])) break; if (sp > XB_SPIN_CAP) { atomicAdd(&bar[XB_TMO], 1u); break; } }
    }
    nloc = mine > 0u ? mine : 1u; nx = cnt > 0u ? cnt : 1u;
}

__device__ __forceinline__ void xcd_barrier(const XcdBarrier& b) {
    asm volatile("s_waitcnt vmcnt(0)" ::: "memory");
    __syncthreads();
    if (threadIdx.x == 0) {
        unsigned* bar = b.bar;
        __builtin_amdgcn_s_waitcnt(0);
        unsigned nloc = b.st[0], nx = b.st[1];
        if (nloc == 0u) { xcd_barrier_complete(bar, b.x, nloc, nx); b.st[0] = nloc; b.st[1] = nx; }
        const unsigned old = xb_add(&bar[XB_XSUB(b.x)], 1u);
        const unsigned gen = old / nloc;
        if (old + 1u == (gen + 1u) * nloc) {
            __builtin_amdgcn_fence(__ATOMIC_RELEASE, "agent");
            asm volatile("s_waitcnt vmcnt(0)" ::: "memory");
            const unsigned og = xb_add(&bar[XB_TOP], 1u);
            const unsigned tg = og / nx;
            if (og + 1u == (tg + 1u) * nx) xb_add(&bar[XB_TOPGEN], 1u);
            else XB_SPIN(xb_ld(&bar[XB_TOPGEN]) == tg, bar);
            __builtin_amdgcn_fence(__ATOMIC_ACQUIRE, "agent");
            xb_add(&bar[XB_XGEN(b.x)], 1u);
            asm volatile("s_waitcnt vmcnt(0)" ::: "memory");
        } else {
            XB_SPIN(xb_ld(&bar[XB_XGEN(b.x)]) == gen, bar);
            __builtin_amdgcn_fence(__ATOMIC_ACQUIRE, "agent");
            asm volatile("s_waitcnt vmcnt(0)" ::: "memory");
        }
    }
    __syncthreads();
}

constexpr int NWAVES = 8;
constexpr int RING_OFF = 0, RING_BYTES = 131072;
constexpr int LDSCTL_OFF = RING_BYTES, MISC_OFF = LDSCTL_OFF + 320;
constexpr int LDS_BYTES = 147456;
constexpr int CW_TMO = 0, CW_CODE = 1, CW_BAR = 4096;
constexpr int NPHASE = 8;
#ifndef MK_N_LAUNCHES
#define MK_N_LAUNCHES 1
#endif

typedef float f32x4 __attribute__((ext_vector_type(4)));
#define LDS_WAIT() asm volatile("s_waitcnt lgkmcnt(0)" ::: "memory")
#define VM_WAIT() asm volatile("s_waitcnt vmcnt(0)" ::: "memory")

template <int MAP>
__device__ __forceinline__ void p0_transpose_item(const float* W, int K, int N, int NP, const float* gain, bf16_t* WT, LAS float* scr, int item, int lane) {
    const int nblk = NP / 32, kb = item / nblk, nb = item % nblk, k0 = 64 * kb, n0 = 32 * nb;
    const int sc = srcmap<MAP>(n0 + (lane & 31));
#pragma unroll 8
    for (int i = 0; i < 32; ++i) { const int kk = 2 * i + (lane >> 5);
        float v = 0.f; if (sc >= 0) { v = W[(size_t)(k0 + kk) * N + sc]; if (gain) v *= gain[k0 + kk]; }
        scr[kk * 33 + (lane & 31)] = v; }
    LDS_WAIT(); asm volatile("" ::: "memory");
    const int c = lane & 7;
#pragma unroll
    for (int j = 0; j < 4; ++j) { const int n = (lane >> 3) + 8 * j; const LAS float* s = scr + (8 * c) * 33 + n;
        v4u o; o.x = pk2(s[0 * 33], s[1 * 33]); o.y = pk2(s[2 * 33], s[3 * 33]); o.z = pk2(s[4 * 33], s[5 * 33]); o.w = pk2(s[6 * 33], s[7 * 33]);
        *(GAS v4u*)(WT + (size_t)(n0 + n) * K + k0 + 8 * c) = o; }
    LDS_WAIT(); asm volatile("" ::: "memory");
}
struct Args { const float* in[13]; float* out; unsigned char* ws; int ph_lo, ph_hi, li, pad; };

__global__ void __launch_bounds__(NWAVES * 64, 2) mk_fwd(Args args) {
    extern __shared__ __attribute__((aligned(16))) unsigned char lds[];
    LAS unsigned char* ldsp = (LAS unsigned char*)lds;
    volatile LAS unsigned* MISC = (volatile LAS unsigned*)(ldsp + MISC_OFF);
    const int tid = threadIdx.x, lane = tid & 63, wave = __builtin_amdgcn_readfirstlane(tid >> 6);
    const int G = gridDim.x; const int vcu = (G % 8 == 0) ? ((int)blockIdx.x % 8) * (G / 8) + (int)blockIdx.x / 8 : (int)blockIdx.x;
    unsigned char* ws = args.ws;
    unsigned* ctl = (unsigned*)(ws + WS_CTL);
    const float* x = args.in[0]; const int* pos = (const int*)args.in[1]; const float* g_pre = args.in[2]; const float* w_in = args.in[3];
    const float* g_q = args.in[4]; const float* w_qb = args.in[5]; const float* g_kv = args.in[6]; const float* w_kvb = args.in[7];
    const float* conv_w = args.in[8]; const float* w_om = args.in[9]; const float* w_oc = args.in[10]; const float* w_out = args.in[11]; const float* g_post = args.in[12];
    float* ssq = (float*)(ws + WS_SSQ); float2* rope = (float2*)(ws + WS_ROPE);
    bf16_t *WQT = (bf16_t*)(ws + WS_WQT), *WKVT = (bf16_t*)(ws + WS_WKVT), *WOMT = (bf16_t*)(ws + WS_WOMT), *WOCT = (bf16_t*)(ws + WS_WOCT), *WOUTT = (bf16_t*)(ws + WS_WOUTT), *WINT = (bf16_t*)(ws + WS_WINT);
    bf16_t *H = (bf16_t*)(ws + WS_H), *AO = (bf16_t*)(ws + WS_AO), *QA = (bf16_t*)(ws + WS_QA), *CKV = (bf16_t*)(ws + WS_CKV), *KR = (bf16_t*)(ws + WS_KR);
    bf16_t *ZS = (bf16_t*)(ws + WS_ZS), *U = (bf16_t*)(ws + WS_U), *T = (bf16_t*)(ws + WS_T), *SG1 = (bf16_t*)(ws + WS_SG1), *SG2 = (bf16_t*)(ws + WS_SG2);
    bf16_t *QN = (bf16_t*)(ws + WS_QN), *QR = (bf16_t*)(ws + WS_QR), *KN = (bf16_t*)(ws + WS_KN), *V = (bf16_t*)(ws + WS_V), *AC = (bf16_t*)(ws + WS_AC), *MG = (bf16_t*)(ws + WS_MG);
    float* OUTF = (float*)(ws + WS_OUTF);

    for (int u = tid; u < (LDS_BYTES - LDSCTL_OFF) / 4; u += NWAVES * 64) ((LAS unsigned*)(ldsp + LDSCTL_OFF))[u] = 0u;
    __syncthreads();
    const int lo = args.ph_lo, hi = args.ph_hi;
    const bool use_bar = (hi - lo) > 1;
    XcdBarrier bar; bar.bar = ctl + CW_BAR + args.li * XCD_BAR_WORDS; bar.x = 0; bar.st = nullptr;
    if (use_bar) bar = xcd_barrier_post(ctl + CW_BAR + args.li * XCD_BAR_WORDS, MISC + 8);
#ifndef PH_EN
#define PH_EN 0xFF
#endif
#define IN(k) (((PH_EN >> (k)) & 1) && lo <= (k) && (k) < hi)
#define SEAM(k) do { if (lo <= (k) && (k) + 1 < hi) xcd_barrier(bar); } while (0)
    const int gw = vcu * NWAVES + wave, NGW = G * NWAVES;

    if (IN(0)) {
        for (int i = (int)blockIdx.x * (NWAVES * 64) + tid; i < S * 32; i += G * NWAVES * 64) {
            const int s = i >> 5, j = i & 31;
            const float inv = exp2f(-(float)(2 * j) / 64.f * 13.287712379549449f);
            const float ang = (float)pos[s] * inv;
            const double a = (double)ang, kq = rint(a * 0.15915494309189535), r = a - kq * 6.283185307179586;
            const float rf = (float)r;
            rope[i] = make_float2(cosf(rf), sinf(rf));
        }
        for (int m = gw; m < S; m += NGW) {
            const GAS f32x4* xr = (const GAS f32x4*)(x + (size_t)m * DM) + lane;
            f32x4 v[8]; float s = 0.f;
#pragma unroll
            for (int j = 0; j < 8; ++j) { v[j] = xr[64 * j]; s += (v[j].x * v[j].x + v[j].y * v[j].y) + (v[j].z * v[j].z + v[j].w * v[j].w); }
            const float r = rsqrtf(wave_sum(s) * (1.f / DM) + RMS_EPS);
            GAS unsigned long long* o8 = (GAS unsigned long long*)(H + (size_t)m * DM) + lane;
#pragma unroll
            for (int j = 0; j < 8; ++j) { const f32x4 gg = ((const GAS f32x4*)g_pre)[lane + 64 * j];
                o8[64 * j] = (unsigned long long)pk2(v[j].x * r * gg.x, v[j].y * r * gg.y) | ((unsigned long long)pk2(v[j].z * r * gg.z, v[j].w * r * gg.w) << 32); }
        }
        LAS float* scr = (LAS float*)(ldsp + RING_OFF + wave * 16384);
        constexpr int I_IN = (DM / 64) * (N1P / 32), I_Q = (QL / 64) * (NQ / 32), I_KV = (KVL / 64) * (NKV / 32), I_O = (DM / 64) * (DM / 32);
        constexpr int NITEMS = I_IN + I_Q + I_KV + 3 * I_O;
        for (int it = gw; it < NITEMS; it += NGW) {
            int r = it;
            if (r < I_IN) { p0_transpose_item<1>(w_in, DM, IN_TOTAL, N1P, nullptr, WINT, scr, r, lane); continue; } r -= I_IN;
            if (r < I_Q) { p0_transpose_item<2>(w_qb, QL, NQ, NQ, g_q, WQT, scr, r, lane); continue; } r -= I_Q;
            if (r < I_KV) { p0_transpose_item<3>(w_kvb, KVL, NKV, NKV, g_kv, WKVT, scr, r, lane); continue; } r -= I_KV;
            if (r < I_O) { p0_transpose_item<0>(w_om, DM, DM, DM, nullptr, WOMT, scr, r, lane); continue; } r -= I_O;
            if (r < I_O) { p0_transpose_item<0>(w_oc, DM, DM, DM, nullptr, WOCT, scr, r, lane); continue; } r -= I_O;
            p0_transpose_item<0>(w_out, DM, DM, DM, nullptr, WOUTT, scr, r, lane);
        }
        __syncthreads();
    }
    SEAM(0);
    if (IN(1)) {
        pg8::Gemm g{H, WINT, S, N1P, DM}; pg8::StaticOrder So; So.init(S, N1P, G, (int)blockIdx.x);
        pg8::EpiP1 E{QA, CKV, KR, ZS, U, T, SG1, SG2, ssq, rope};
        pg8::gemm_phase<pg8::EpiP1, pg8::StaticOrder, true, true>(ldsp + RING_OFF, g, So, E);
    }
    SEAM(1);
    if (IN(2)) {
        { pg8::Gemm g{QA, WQT, S, NQ, QL}; pg8::StaticOrder So; So.init(S, NQ, G, (int)blockIdx.x);
          pg8::EpiQ E{QN, QR, ssq, rope};
          pg8::gemm_phase<pg8::EpiQ, pg8::StaticOrder, true, true>(ldsp + RING_OFF, g, So, E); }
        { pg8::Gemm g{CKV, WKVT, S, NKV, KVL}; pg8::StaticOrder So; So.init(S, NKV, G, (int)blockIdx.x);
          pg8::EpiKV E{KN, V, ssq};
          pg8::gemm_phase<pg8::EpiKV, pg8::StaticOrder, true, true>(ldsp + RING_OFF, g, So, E); }
        for (size_t i = (size_t)blockIdx.x * (NWAVES * 64) + tid; i < (size_t)S * DM / 8; i += (size_t)G * NWAVES * 64) {
            const int s = (int)(i >> 8), c8 = (int)(i & 255) * 8; const size_t e = (size_t)s * DM + c8;
            f32x4 a0, a1, b0, b1, c0, c1, t0, t1;
            { const v4u q_ = *(const GAS v4u*)(U + e); pg8::unpk8(q_, a0, a1); }
            if (s >= 1) { const v4u q_ = *(const GAS v4u*)(U + e - DM); pg8::unpk8(q_, b0, b1); } else { b0 = (f32x4){0.f, 0.f, 0.f, 0.f}; b1 = b0; }
            if (s >= 2) { const v4u q_ = *(const GAS v4u*)(U + e - 2 * DM); pg8::unpk8(q_, c0, c1); } else { c0 = (f32x4){0.f, 0.f, 0.f, 0.f}; c1 = c0; }
            { const v4u q_ = *(const GAS v4u*)(T + e); pg8::unpk8(q_, t0, t1); }
            const f32x4 w00 = *(const GAS f32x4*)(conv_w + c8), w01 = *(const GAS f32x4*)(conv_w + c8 + 4);
            const f32x4 w10 = *(const GAS f32x4*)(conv_w + DM + c8), w11 = *(const GAS f32x4*)(conv_w + DM + c8 + 4);
            const f32x4 w20 = *(const GAS f32x4*)(conv_w + 2 * DM + c8), w21 = *(const GAS f32x4*)(conv_w + 2 * DM + c8 + 4);
            const f32x4 r0 = t0 * (w00 * c0 + w10 * b0 + w20 * a0), r1 = t1 * (w01 * c1 + w11 * b1 + w21 * a1);
            v4u o; o.x = pk2(r0[0], r0[1]); o.y = pk2(r0[2], r0[3]); o.z = pk2(r1[0], r1[1]); o.w = pk2(r1[2], r1[3]);
            *(GAS v4u*)(AC + e) = o;
        }
    }
    SEAM(2);
    if (IN(3)) {
        att::Tens AT{QN, QR, KN, KR, V, ZS, AO};
        att::attn_phase(AT, (char*)lds + RING_OFF);
    }
    SEAM(3);
    if (IN(4)) {
        pg8::Gemm g{AO, WOMT, S, DM, DM}; pg8::StaticOrder So; So.init(S, DM, G, (int)blockIdx.x);
        pg8::EpiY1 E{OUTF, SG1};
        pg8::gemm_phase<pg8::EpiY1, pg8::StaticOrder, true, true>(ldsp + RING_OFF, g, So, E);
    }
    SEAM(4);
    if (IN(5)) {
        pg8::Gemm g{AC, WOCT, S, DM, DM}; pg8::StaticOrder So; So.init(S, DM, G, (int)blockIdx.x);
        pg8::EpiY2 E{OUTF, SG2, MG};
        pg8::gemm_phase<pg8::EpiY2, pg8::StaticOrder, true, true>(ldsp + RING_OFF, g, So, E);
    }
    SEAM(5);
    if (IN(6)) {
        pg8::Gemm g{MG, WOUTT, S, DM, DM}; pg8::StaticOrder So; So.init(S, DM, G, (int)blockIdx.x);
        pg8::EpiOut E{OUTF};
        pg8::gemm_phase<pg8::EpiOut, pg8::StaticOrder, true, true>(ldsp + RING_OFF, g, So, E);
    }
    SEAM(6);
    if (IN(7)) {
        for (int m = gw; m < S; m += NGW) {
            const GAS f32x4* yr = (const GAS f32x4*)(OUTF + (size_t)m * DM) + lane; const GAS f32x4* xr = (const GAS f32x4*)(x + (size_t)m * DM) + lane;
            f32x4 v[8]; float s = 0.f;
#pragma unroll
            for (int j = 0; j < 8; ++j) { v[j] = yr[64 * j]; s += (v[j].x * v[j].x + v[j].y * v[j].y) + (v[j].z * v[j].z + v[j].w * v[j].w); }
            const float r = rsqrtf(wave_sum(s) * (1.f / DM) + RMS_EPS);
            GAS f32x4* orow = (GAS f32x4*)(args.out + (size_t)m * DM) + lane;
#pragma unroll
            for (int j = 0; j < 8; ++j) { const f32x4 gg = ((const GAS f32x4*)g_post)[lane + 64 * j]; orow[64 * j] = xr[64 * j] + v[j] * r * gg; }
        }
    }
#undef IN
#undef SEAM
}

__global__ void __launch_bounds__(256) k_prep_misc(const int* pos, float2* rope, float* ssq) {
    const int i = blockIdx.x * 256 + threadIdx.x;
    if (i < S * 32) {
        const int s = i >> 5, j = i & 31;
        const float inv = exp2f(-(float)(2 * j) / 64.f * 13.287712379549449f);
        const float ang = (float)pos[s] * inv;
        const double a = (double)ang;
        const double k = rint(a * 0.15915494309189535);
        const double r = a - k * 6.283185307179586;
        const float rf = (float)r;
        rope[i] = make_float2(cosf(rf), sinf(rf));
    }
    if (i < S * 2) ssq[i] = 0.f;
}
__global__ void __launch_bounds__(256) k_xnorm(const float* x, const float* g, bf16_t* H) {
    const int row = blockIdx.x * 4 + (threadIdx.x >> 6), lane = threadIdx.x & 63;
    const float4* xr = (const float4*)(x + (size_t)row * DM);
    float4 v[8]; float s = 0.f;
#pragma unroll
    for (int j = 0; j < 8; ++j) { v[j] = xr[lane + 64 * j]; s += v[j].x * v[j].x + v[j].y * v[j].y + v[j].z * v[j].z + v[j].w * v[j].w; }
    const float r = rsqrtf(wave_sum(s) * (1.f / DM) + RMS_EPS);
#pragma unroll
    for (int j = 0; j < 8; ++j) {
        const float4 gg = ((const float4*)g)[lane + 64 * j];
        ushort4 o; o.x = f2bf(v[j].x * r * gg.x); o.y = f2bf(v[j].y * r * gg.y); o.z = f2bf(v[j].z * r * gg.z); o.w = f2bf(v[j].w * r * gg.w);
        ((ushort4*)(H + (size_t)row * DM))[lane + 64 * j] = o;
    }
}

template <int ND, class F>
__global__ void __launch_bounds__(256) nv_dots(F f) {
    const int c = blockIdx.x * 256 + threadIdx.x, r0 = blockIdx.y * 8;
    const bool act = c < f.ncols; const int cc = act ? c : 0;
    float acc[ND][8];
#pragma unroll
    for (int d = 0; d < ND; ++d)
#pragma unroll
        for (int i = 0; i < 8; ++i) acc[d][i] = 0.f;
    int wc[ND];
#pragma unroll
    for (int d = 0; d < ND; ++d) wc[d] = f.wcol(d, cc);
    for (int k = 0; k < f.K; k += 8) {
        float a[8][8];
#pragma unroll
        for (int i = 0; i < 8; ++i) {
            const v4u q = *(const v4u*)(f.A + (size_t)(r0 + i) * f.lda + k);
#pragma unroll
            for (int e = 0; e < 4; ++e) { a[i][2 * e] = __uint_as_float(q[e] << 16); a[i][2 * e + 1] = __uint_as_float(q[e] & 0xffff0000u); }
        }
#pragma unroll
        for (int e = 0; e < 8; ++e) {
            const float gk = f.gain ? f.gain[k + e] : 1.f;
#pragma unroll
            for (int d = 0; d < ND; ++d) {
                const float w = f.W[(size_t)(k + e) * f.ldw + wc[d]] * gk;
#pragma unroll
                for (int i = 0; i < 8; ++i) acc[d][i] = fmaf(a[i][e], w, acc[d][i]);
            }
        }
    }
#pragma unroll
    for (int i = 0; i < 8; ++i) { float v[ND];
#pragma unroll
        for (int d = 0; d < ND; ++d) v[d] = acc[d][i];
        f.out(r0 + i, cc, v, act); }
}
struct FBase { const bf16_t* A; int lda; const float* W; int ldw; const float* gain; int K; int ncols; };
struct F_LAT : FBase { int cbase; bf16_t* dst; float* ssq; int which;
    __device__ int wcol(int, int c) const { return cbase + c; }
    __device__ void out(int row, int c, const float (&v)[1], bool) const { dst[(size_t)row * 512 + c] = f2bf(v[0]); const float s = wave_sum(v[0] * v[0]); if ((threadIdx.x & 63) == 0) atomicAdd(ssq + row * 2 + which, s); } };
struct F_KR : FBase { bf16_t* dst; const float2* rope;
    __device__ int wcol(int d, int c) const { return C_KR + 32 * d + c; }
    __device__ void out(int row, int c, const float (&v)[2], bool act) const { if (!act) return; const float2 cs = rope[row * 32 + c];
        dst[(size_t)row * 64 + c] = f2bf(v[0] * cs.x - v[1] * cs.y); dst[(size_t)row * 64 + 32 + c] = f2bf(v[0] * cs.y + v[1] * cs.x); } };
struct F_ACT : FBase { int cbase; bf16_t* dst; int mode;
    __device__ int wcol(int, int c) const { return cbase + c; }
    __device__ void out(int row, int c, const float (&v)[1], bool) const { dst[(size_t)row * DM + c] = f2bf(mode == 0 ? silu_f(v[0]) : sigm_f(v[0])); } };
struct F_CV : FBase { bf16_t* U; bf16_t* T;
    __device__ int wcol(int d, int c) const { return (d == 0 ? C_CIN : d == 1 ? C_BG : d == 2 ? C_CG : C_ZC) + c; }
    __device__ void out(int row, int c, const float (&v)[4], bool) const { U[(size_t)row * DM + c] = f2bf(v[2] * v[0]); T[(size_t)row * DM + c] = f2bf(v[1] * silu_f(v[3])); } };
struct F_QN : FBase { bf16_t* dst; const float* ssq;
    __device__ int wcol(int, int c) const { return 192 * (c >> 7) + (c & 127); }
    __device__ void out(int row, int c, const float (&v)[1], bool) const { const float r = rsqrtf(ssq[row * 2] * (1.f / QL) + RMS_EPS); dst[(size_t)row * 2048 + c] = f2bf(v[0] * r * QSCALE); } };
struct F_QR : FBase { bf16_t* dst; const float* ssq; const float2* rope;
    __device__ int wcol(int d, int c) const { return 192 * (c >> 5) + 128 + 32 * d + (c & 31); }
    __device__ void out(int row, int c, const float (&v)[2], bool) const { const float r = rsqrtf(ssq[row * 2] * (1.f / QL) + RMS_EPS) * QSCALE; const float2 cs = rope[row * 32 + (c & 31)];
        const int h = c >> 5, i = c & 31; const float x1 = v[0] * r, x2 = v[1] * r;
        dst[(size_t)row * 1024 + 64 * h + i] = f2bf(x1 * cs.x - x2 * cs.y); dst[(size_t)row * 1024 + 64 * h + 32 + i] = f2bf(x1 * cs.y + x2 * cs.x); } };
struct F_KV : FBase { bf16_t* dst; const float* ssq; int off;
    __device__ int wcol(int, int c) const { return 256 * (c >> 7) + off + (c & 127); }
    __device__ void out(int row, int c, const float (&v)[1], bool) const { const float r = rsqrtf(ssq[row * 2 + 1] * (1.f / KVL) + RMS_EPS); dst[(size_t)row * 2048 + c] = f2bf(v[0] * r); } };
struct F_Y1 : FBase { float* tmp; const bf16_t* sg;
    __device__ int wcol(int, int c) const { return c; }
    __device__ void out(int row, int c, const float (&v)[1], bool) const { tmp[(size_t)row * DM + c] = v[0] * bf2f(sg[(size_t)row * DM + c]); } };
struct F_Y2 : FBase { const float* tmp; const bf16_t* sg; bf16_t* mg;
    __device__ int wcol(int, int c) const { return c; }
    __device__ void out(int row, int c, const float (&v)[1], bool) const { mg[(size_t)row * DM + c] = f2bf(tmp[(size_t)row * DM + c] + v[0] * bf2f(sg[(size_t)row * DM + c])); } };
struct F_OUT : FBase { float* outf;
    __device__ int wcol(int, int c) const { return c; }
    __device__ void out(int row, int c, const float (&v)[1], bool) const { outf[(size_t)row * DM + c] = v[0]; } };

__global__ void __launch_bounds__(256) k_conv(const bf16_t* U, const bf16_t* T, const float* cw, bf16_t* AC) {
    const size_t i = (size_t)blockIdx.x * 256 + threadIdx.x;
    const int s = (int)(i / DM), c = (int)(i % DM);
    const float u0 = bf2f(U[i]), u1 = s >= 1 ? bf2f(U[i - DM]) : 0.f, u2 = s >= 2 ? bf2f(U[i - 2 * DM]) : 0.f;
    const float cv = cw[c] * u2 + cw[DM + c] * u1 + cw[2 * DM + c] * u0;
    AC[i] = f2bf(bf2f(T[i]) * cv);
}

constexpr int NA_LDS = (64 * 193 * 2 + 64 * 132 + 64 * 65) * 4;
__global__ void __launch_bounds__(256) nv_attn(const bf16_t* QN, const bf16_t* QR, const bf16_t* KN, const bf16_t* KR, const bf16_t* V, const bf16_t* ZS, bf16_t* AO) {
    extern __shared__ __attribute__((aligned(16))) float sm[];
    float* Qs = sm; float* Ks = Qs + 64 * 193; float* Vs = Ks + 64 * 193; float* Ps = Vs + 64 * 132;
    const int qb = blockIdx.x, h = blockIdx.y, tid = threadIdx.x, r = tid >> 2, qq = tid & 3, q0 = qb * 64;
    for (int i = tid; i < 64 * 192; i += 256) { const int rr = i / 192, d = i % 192;
        Qs[rr * 193 + d] = d < 128 ? bf2f(QN[(size_t)(q0 + rr) * 2048 + h * 128 + d]) : bf2f(QR[(size_t)(q0 + rr) * 1024 + h * 64 + d - 128]); }
    float m = -1e30f, l = 0.f, o[32];
#pragma unroll
    for (int d = 0; d < 32; ++d) o[d] = 0.f;
    for (int kt = 0; kt <= qb; ++kt) {
        __syncthreads();
        const int k0 = kt * 64;
        for (int i = tid; i < 64 * 192; i += 256) { const int rr = i / 192, d = i % 192;
            Ks[rr * 193 + d] = d < 128 ? bf2f(KN[(size_t)(k0 + rr) * 2048 + h * 128 + d]) : bf2f(KR[(size_t)(k0 + rr) * 64 + d - 128]); }
        for (int i = tid; i < 64 * 128; i += 256) { const int rr = i >> 7, d = i & 127; Vs[rr * 132 + (d >> 5) * 33 + (d & 31)] = bf2f(V[(size_t)(k0 + rr) * 2048 + h * 128 + d]); }
        __syncthreads();
        float s[16]; float mx = -INFINITY;
#pragma unroll
        for (int j = 0; j < 16; ++j) { const int key = 4 * j + qq; float a = 0.f;
            for (int d = 0; d < 192; ++d) a = fmaf(Qs[r * 193 + d], Ks[key * 193 + d], a);
            if (k0 + key > q0 + r) a = -INFINITY;
            s[j] = a; mx = fmaxf(mx, a); }
        mx = fmaxf(mx, __shfl_xor(mx, 1)); mx = fmaxf(mx, __shfl_xor(mx, 2));
        const float mn = fmaxf(m, mx), alpha = exp2f(m - mn); m = mn;
        float ps = 0.f;
#pragma unroll
        for (int j = 0; j < 16; ++j) { const float p = exp2f(s[j] - mn); ps += p; Ps[r * 65 + 4 * j + qq] = p; }
        ps += __shfl_xor(ps, 1); ps += __shfl_xor(ps, 2);
        l = l * alpha + ps;
        __syncthreads();
#pragma unroll
        for (int d = 0; d < 32; ++d) o[d] *= alpha;
        for (int key = 0; key < 64; ++key) { const float p = Ps[r * 65 + key];
#pragma unroll
            for (int d = 0; d < 32; ++d) o[d] = fmaf(p, Vs[key * 132 + qq * 33 + d], o[d]); }
    }
    const float li = 1.f / l;
#pragma unroll
    for (int d = 0; d < 32; ++d) { const size_t idx = (size_t)(q0 + r) * 2048 + h * 128 + qq * 32 + d; AO[idx] = f2bf(o[d] * li * bf2f(ZS[idx])); }
}

__global__ void __launch_bounds__(256) k_final(const float* x, const float* outf, const float* g, float* out) {
    const int row = blockIdx.x * 4 + (threadIdx.x >> 6), lane = threadIdx.x & 63;
    const float4* yr = (const float4*)(outf + (size_t)row * DM); const float4* xr = (const float4*)(x + (size_t)row * DM);
    float4 v[8]; float s = 0.f;
#pragma unroll
    for (int j = 0; j < 8; ++j) { v[j] = yr[lane + 64 * j]; s += v[j].x * v[j].x + v[j].y * v[j].y + v[j].z * v[j].z + v[j].w * v[j].w; }
    const float r = rsqrtf(wave_sum(s) * (1.f / DM) + RMS_EPS);
#pragma unroll
    for (int j = 0; j < 8; ++j) { const float4 gg = ((const float4*)g)[lane + 64 * j], xx = xr[lane + 64 * j];
        float4 o; o.x = xx.x + v[j].x * r * gg.x; o.y = xx.y + v[j].y * r * gg.y; o.z = xx.z + v[j].z * r * gg.z; o.w = xx.w + v[j].w * r * gg.w;
        ((float4*)(out + (size_t)row * DM))[lane + 64 * j] = o; }
}


template <int ND, class F> static void run_dots(const F& f, hipStream_t st) {
    hipLaunchKernelGGL((nv_dots<ND, F>), dim3((f.ncols + 255) / 256, S / 8), dim3(256), 0, st, f);
}
#ifndef IMPL_MASK
#define IMPL_MASK 0xFF
#endif
extern "C" void kernel_launch(void* const* d_in, const int* in_sizes, int n_in, void* d_out, int out_size, void* d_ws, size_t ws_size, hipStream_t stream) {
    static int grid = 0;
    if (grid == 0) {
        if (n_in != 13 || in_sizes[0] != S * DM || in_sizes[3] != DM * IN_TOTAL || out_size != S * DM || ws_size < WS_END) {
            fprintf(stderr, "kernel_launch: unexpected shapes / workspace (n_in %d, ws %zu, need %zu)\n", n_in, ws_size, (size_t)WS_END); grid = -1; return; }
        int dev = 0, cus = 0, per_cu = 0;
        if (hipGetDevice(&dev) != hipSuccess || hipDeviceGetAttribute(&cus, hipDeviceAttributeMultiprocessorCount, dev) != hipSuccess) { grid = -1; return; }
        if (hipFuncSetAttribute((const void*)mk_fwd, hipFuncAttributeMaxDynamicSharedMemorySize, LDS_BYTES) != hipSuccess) { fprintf(stderr, "kernel_launch: hipFuncSetAttribute failed\n"); grid = -1; return; }
        (void)hipFuncSetAttribute((const void*)nv_attn, hipFuncAttributeMaxDynamicSharedMemorySize, NA_LDS);
        if (hipOccupancyMaxActiveBlocksPerMultiprocessor(&per_cu, (const void*)mk_fwd, NWAVES * 64, LDS_BYTES) != hipSuccess || per_cu < 1) { fprintf(stderr, "kernel_launch: occupancy query says %d\n", per_cu); per_cu = 1; }
        (void)hipGetLastError();
        grid = cus * 1;
        if (per_cu < 1) grid = -1;
    }
    if (grid < 0) return;
    if (hipMemsetAsync((char*)d_ws + WS_CTL, 0, CTL_ZERO_BYTES, stream) != hipSuccess) { fprintf(stderr, "kernel_launch: memset failed\n"); return; }
    Args a; memset(&a, 0, sizeof a);
    for (int i = 0; i < 13; ++i) a.in[i] = (const float*)d_in[i];
    a.out = (float*)d_out; a.ws = (unsigned char*)d_ws;
    if (MK_N_LAUNCHES == 1 && (IMPL_MASK & 0xFF) == 0xFF) {
        a.ph_lo = 0; a.ph_hi = NPHASE; a.li = 0;
        void* kargs[] = {&a};
        hipError_t e = hipLaunchCooperativeKernel((const void*)mk_fwd, dim3(grid), dim3(NWAVES * 64), kargs, LDS_BYTES, stream);
        if (e != hipSuccess) fprintf(stderr, "kernel_launch: cooperative launch failed: %s (grid %d)\n", hipGetErrorString(e), grid);
        return;
    }
    const float* x = (const float*)d_in[0]; const int* pos = (const int*)d_in[1]; const float* g_pre = (const float*)d_in[2]; const float* w_in = (const float*)d_in[3];
    const float* g_q = (const float*)d_in[4]; const float* w_qb = (const float*)d_in[5]; const float* g_kv = (const float*)d_in[6]; const float* w_kvb = (const float*)d_in[7];
    const float* conv_w = (const float*)d_in[8]; const float* w_om = (const float*)d_in[9]; const float* w_oc = (const float*)d_in[10]; const float* w_out = (const float*)d_in[11];
    const float* g_post = (const float*)d_in[12];
    unsigned char* ws = (unsigned char*)d_ws;
    float* ssq = (float*)(ws + WS_SSQ); float2* rope = (float2*)(ws + WS_ROPE);
    bf16_t *H = (bf16_t*)(ws + WS_H), *AO = (bf16_t*)(ws + WS_AO), *QA = (bf16_t*)(ws + WS_QA), *CKV = (bf16_t*)(ws + WS_CKV), *KR = (bf16_t*)(ws + WS_KR);
    bf16_t *ZS = (bf16_t*)(ws + WS_ZS), *U = (bf16_t*)(ws + WS_U), *T = (bf16_t*)(ws + WS_T), *SG1 = (bf16_t*)(ws + WS_SG1), *SG2 = (bf16_t*)(ws + WS_SG2);
    bf16_t *QN = (bf16_t*)(ws + WS_QN), *QR = (bf16_t*)(ws + WS_QR), *KN = (bf16_t*)(ws + WS_KN), *V = (bf16_t*)(ws + WS_V), *AC = (bf16_t*)(ws + WS_AC), *MG = (bf16_t*)(ws + WS_MG);
    float* OUTF = (float*)(ws + WS_OUTF);
    for (int k = 0; k < NPHASE; ++k) {
        if ((IMPL_MASK >> k) & 1) { a.ph_lo = k; a.ph_hi = k + 1; a.li = 0; hipLaunchKernelGGL(mk_fwd, dim3(grid), dim3(NWAVES * 64), LDS_BYTES, stream, a); continue; }
        switch (k) {
        case 0: hipLaunchKernelGGL(k_prep_misc, dim3(S * 32 / 256), dim3(256), 0, stream, pos, rope, ssq + S * 2);
                hipLaunchKernelGGL(k_xnorm, dim3(S / 4), dim3(256), 0, stream, x, g_pre, H); break;
        case 1: { { F_LAT f; memset(&f, 0, sizeof f); f.A = H; f.lda = DM; f.W = w_in; f.ldw = IN_TOTAL; f.gain = nullptr; f.K = DM; f.ncols = 512; f.cbase = C_QA; f.dst = QA; f.ssq = ssq; f.which = 0; run_dots<1>(f, stream);
                    f.cbase = C_CKV; f.dst = CKV; f.which = 1; run_dots<1>(f, stream); }
                  { F_KR f; memset(&f, 0, sizeof f); f.A = H; f.lda = DM; f.W = w_in; f.ldw = IN_TOTAL; f.gain = nullptr; f.K = DM; f.ncols = 32; f.dst = KR; f.rope = rope; run_dots<2>(f, stream); }
                  { F_ACT f; memset(&f, 0, sizeof f); f.A = H; f.lda = DM; f.W = w_in; f.ldw = IN_TOTAL; f.gain = nullptr; f.K = DM; f.ncols = DM; f.cbase = C_ZM; f.dst = ZS; f.mode = 0; run_dots<1>(f, stream);
                    f.cbase = C_GM; f.dst = SG1; f.mode = 1; run_dots<1>(f, stream);
                    f.cbase = C_GC; f.dst = SG2; f.mode = 1; run_dots<1>(f, stream); }
                  { F_CV f; memset(&f, 0, sizeof f); f.A = H; f.lda = DM; f.W = w_in; f.ldw = IN_TOTAL; f.gain = nullptr; f.K = DM; f.ncols = DM; f.U = U; f.T = T; run_dots<4>(f, stream); } } break;
        case 2: { { F_QN f; memset(&f, 0, sizeof f); f.A = QA; f.lda = QL; f.W = w_qb; f.ldw = 3072; f.gain = g_q; f.K = QL; f.ncols = 2048; f.dst = QN; f.ssq = ssq; run_dots<1>(f, stream); }
                  { F_QR f; memset(&f, 0, sizeof f); f.A = QA; f.lda = QL; f.W = w_qb; f.ldw = 3072; f.gain = g_q; f.K = QL; f.ncols = 512; f.dst = QR; f.ssq = ssq; f.rope = rope; run_dots<2>(f, stream); }
                  { F_KV f; memset(&f, 0, sizeof f); f.A = CKV; f.lda = KVL; f.W = w_kvb; f.ldw = 4096; f.gain = g_kv; f.K = KVL; f.ncols = 2048; f.dst = KN; f.ssq = ssq; f.off = 0; run_dots<1>(f, stream);
                    f.dst = V; f.off = 128; run_dots<1>(f, stream); }
                  hipLaunchKernelGGL(k_conv, dim3(S * DM / 256), dim3(256), 0, stream, U, T, conv_w, AC); } break;
        case 3: hipLaunchKernelGGL(nv_attn, dim3(S / 64, NH), dim3(256), NA_LDS, stream, QN, QR, KN, KR, V, ZS, AO); break;
        case 4: { F_Y1 f; memset(&f, 0, sizeof f); f.A = AO; f.lda = DM; f.W = w_om; f.ldw = DM; f.gain = nullptr; f.K = DM; f.ncols = DM; f.tmp = OUTF; f.sg = SG1; run_dots<1>(f, stream); } break;
        case 5: { F_Y2 f; memset(&f, 0, sizeof f); f.A = AC; f.lda = DM; f.W = w_oc; f.ldw = DM; f.gain = nullptr; f.K = DM; f.ncols = DM; f.tmp = OUTF; f.sg = SG2; f.mg = MG; run_dots<1>(f, stream); } break;
        case 6: { F_OUT f; memset(&f, 0, sizeof f); f.A = MG; f.lda = DM; f.W = w_out; f.ldw = DM; f.gain = nullptr; f.K = DM; f.ncols = DM; f.outf = OUTF; run_dots<1>(f, stream); } break;
        default: hipLaunchKernelGGL(k_final, dim3(S / 4), dim3(256), 0, stream, x, OUTF, g_post, (float*)d_out); break;
        }
    }
}
```

```cpp
#define MK_N_LAUNCHES 1
#include <hip/hip_runtime.h>
#include <cstdio>
#include <cstdint>
#include <cstring>

constexpr int S = 8192, DM = 2048, NH = 16, QL = 512, KVL = 512;
constexpr int IN_TOTAL = 15424;
constexpr int C_QA = 0, C_CKV = 512, C_KR = 1024, C_ZM = 1088, C_CIN = 3136, C_BG = 5184, C_CG = 7232, C_ZC = 9280, C_GM = 11328, C_GC = 13376;
constexpr int N1P = 61 * 256;
constexpr int NQ = 3072, NKV = 4096;
constexpr float RMS_EPS = 1e-6f;
constexpr float QSCALE = 0.07216878364870322f * 1.4426950408889634f;

constexpr size_t MiB = 1u << 20;
constexpr size_t WS_CTL = 0, CTL_ZERO_BYTES = 1 * MiB;
constexpr size_t WS_SSQ = 512 * 1024;
constexpr size_t WS_ROPE = 2 * MiB;
constexpr size_t WS_WQT = 4 * MiB, WS_WKVT = 7 * MiB, WS_WOMT = 11 * MiB, WS_WOCT = 19 * MiB, WS_WOUTT = 27 * MiB, WS_WINT = 35 * MiB;
constexpr size_t WS_H = 96 * MiB;
constexpr size_t WS_AO = WS_H;
constexpr size_t WS_QA = 128 * MiB, WS_CKV = 136 * MiB, WS_KR = 144 * MiB;
constexpr size_t WS_ZS = 146 * MiB, WS_U = 178 * MiB, WS_T = 210 * MiB, WS_SG1 = 242 * MiB, WS_SG2 = 274 * MiB;
constexpr size_t WS_QN = 306 * MiB, WS_QR = 338 * MiB, WS_KN = 354 * MiB, WS_V = 386 * MiB;
constexpr size_t WS_AC = 418 * MiB, WS_END = 450 * MiB;
constexpr size_t WS_MG = WS_U;
constexpr size_t WS_OUTF = WS_QN;
static_assert(WS_WINT + (size_t)N1P * DM * 2 <= WS_H, "ws map");

typedef unsigned short bf16_t;
typedef unsigned v4u __attribute__((ext_vector_type(4)));
#define GAS __attribute__((address_space(1)))
#define LAS __attribute__((address_space(3)))
__device__ __forceinline__ float bf2f(bf16_t v) { return __uint_as_float((unsigned)v << 16); }
__device__ __forceinline__ bf16_t f2bf(float f) { unsigned u = __float_as_uint(f); return (bf16_t)((u + 0x7fffu + ((u >> 16) & 1u)) >> 16); }
__device__ __forceinline__ unsigned pk2(float lo, float hi) { return (unsigned)f2bf(lo) | ((unsigned)f2bf(hi) << 16); }
__device__ __forceinline__ float silu_f(float v) { return v / (1.f + expf(-v)); }
__device__ __forceinline__ float sigm_f(float v) { return 1.f / (1.f + expf(-v)); }
__device__ __forceinline__ float fsigm(float v) { return __builtin_amdgcn_rcpf(1.f + __builtin_amdgcn_exp2f(-1.4426950408889634f * v)); }
__device__ __forceinline__ float wave_sum(float v) {
#pragma unroll
    for (int o = 1; o < 64; o <<= 1) v += __shfl_xor(v, o);
    return v;
}
template <int MAP> __device__ __forceinline__ int srcmap(int np) {
    if (MAP == 1) {
        const int t = np >> 8, c = np & 255;
        if (t < 4) return np;
        if (t == 4) return (c & 127) < 32 ? C_KR + 32 * (c >> 7) + (c & 127) : -1;
        if (t < 13) return C_ZM + np - 5 * 256;
        if (t < 45) { const int tt = t - 13, kind = 2 * (c >> 7) + ((c >> 2) & 1), ch = 64 * tt + 4 * ((c & 127) >> 3) + (c & 3);
            return (kind == 0 ? C_CIN : kind == 1 ? C_BG : kind == 2 ? C_CG : C_ZC) + ch; }
        if (t < 53) return C_GM + np - 45 * 256;
        return C_GC + np - 53 * 256;
    }
    if (MAP == 2) {
        if (np < 2048) return 192 * (np >> 7) + (np & 127);
        const int t = (np - 2048) >> 8, c = np & 255, head = 4 * t + ((c & 127) >> 5);
        return 192 * head + 128 + 32 * (c >> 7) + (c & 31);
    }
    if (MAP == 3) { const int h = (np & 2047) >> 7, d = np & 127; return 256 * h + (np >= 2048 ? 128 : 0) + d; }
    return np;
}

namespace pg8 {
#define PG8_LAS __attribute__((address_space(3)))
typedef unsigned short bf16_t;
typedef short bf16x8 __attribute__((ext_vector_type(8)));
typedef float f32x4 __attribute__((ext_vector_type(4)));
typedef unsigned u32x4 __attribute__((ext_vector_type(4)));
constexpr int BM = 256, BK = 64, HALF = 128, HTB = HALF * BK * 2  , STAGE_BYTES = 8 * HTB, NXCD = 8, WGM = 8;

__host__ __device__ __forceinline__ int lds_byte(int r, int c) { const int st = (r >> 4) * 2 + (c >> 5), rr = r & 15, cc = c & 31, ob = rr * 64 + cc * 2; return st * 1024 + (ob ^ (((ob >> 9) & 1) << 5)); }
__host__ __device__ __forceinline__ void stage_rc(int b, int& R, int& C) { const int st = b / 1024, sb = b % 1024, swz = sb ^ (((sb >> 9) & 1) << 5); R = (st >> 1) * 16 + swz / 64; C = (st & 1) * 32 + (swz % 64) / 2; }
__host__ __device__ __forceinline__ int perm32(int rho) { const int n = rho >> 4, i = rho & 15; return 8 * (i >> 2) + 4 * n + (i & 3); }

struct Unit { int pm, pn; };
struct Gemm { const bf16_t* A; const bf16_t* Bt; int M, N, K; };

struct StaticOrder {
    int nM, nN, nwg, G, c;
    __host__ __device__ void init(int M, int N, int G_, int c_) { nM = M / BM; nN = N / BM; nwg = nM * nN; G = G_; c = c_; }
    __host__ __device__ bool next(int i, Unit& u) const {
        const long L = (long)i * G + c; if (L >= nwg) return false;
        int wgid = (int)L; { const int q = nwg / NXCD, r = nwg % NXCD, xcd = wgid % NXCD, off = wgid / NXCD; wgid = (xcd < r ? xcd * (q + 1) : r * (q + 1) + (xcd - r) * q) + off; }
        const int nig = WGM * nN, gid = wgid / nig, fm = gid * WGM, gsz = (nM - fm) < WGM ? (nM - fm) : WGM;
        u.pm = fm + ((wgid % nig) % gsz); u.pn = (wgid % nig) / gsz; return true;
    }
    __device__ __forceinline__ void a_ready(const Unit&) const {}
    __device__ __forceinline__ void done(const Unit&) const {}
};

__device__ __forceinline__ unsigned cvt_pk_bf16(float lo, float hi) { unsigned r; asm volatile("v_cvt_pk_bf16_f32 %0, %1, %2" : "=v"(r) : "v"(lo), "v"(hi)); return r; }
typedef float f32x2 __attribute__((ext_vector_type(2)));

__device__ __forceinline__ u32x4 pk8(const f32x4& a, const f32x4& b) { u32x4 w; w.x = cvt_pk_bf16(a[0], a[1]); w.y = cvt_pk_bf16(a[2], a[3]); w.z = cvt_pk_bf16(b[0], b[1]); w.w = cvt_pk_bf16(b[2], b[3]); return w; }
__device__ __forceinline__ float fsig(float v) { return __builtin_amdgcn_rcpf(1.f + __builtin_amdgcn_exp2f(-1.4426950408889634f * v)); }
__device__ __forceinline__ f32x4 sig4(const f32x4& v) { return (f32x4){fsig(v[0]), fsig(v[1]), fsig(v[2]), fsig(v[3])}; }
__device__ __forceinline__ f32x4 silu4(const f32x4& v) { return v * sig4(v); }
struct EpiP1 {
    static constexpr bool PERM = true, AFTER_DRAIN = false;
    bf16_t *QA, *CKV, *KR, *ZS, *U, *T, *SG1, *SG2; float* ssq; const float2* rope;
    __device__ __forceinline__ void operator()(const f32x4 (&acc)[2][2][4][2], const Unit& u, int wr, int wc, int fr, int fq) const {
        const int pn = u.pn, row0 = u.pm * BM + wr * 64 + fr, cg = wc * 4 + fq;
        if (pn < 4) {
            bf16_t* dst = (pn < 2 ? QA : CKV) + (pn & 1) * 256 + 8 * cg; const int which = pn >> 1;
#pragma unroll
            for (int ai = 0; ai < 2; ++ai)
#pragma unroll
                for (int m = 0; m < 4; ++m) { const int row = row0 + ai * HALF + m * 16; float ss = 0.f;
#pragma unroll
                    for (int bj = 0; bj < 2; ++bj) { const f32x4 v0 = acc[ai][bj][m][0], v1 = acc[ai][bj][m][1];
                        *(u32x4*)(dst + (size_t)row * 512 + bj * HALF) = pk8(v0, v1);
                        ss += (v0[0] * v0[0] + v0[1] * v0[1]) + (v0[2] * v0[2] + v0[3] * v0[3]) + (v1[0] * v1[0] + v1[1] * v1[1]) + (v1[2] * v1[2] + v1[3] * v1[3]); }
                    ss += __shfl_xor(ss, 16); ss += __shfl_xor(ss, 32);
                    if (fq == 0) atomicAdd(ssq + row * 2 + which, ss); }
        } else if (pn == 4) {
            if (wc == 0) {
#pragma unroll
                for (int ai = 0; ai < 2; ++ai)
#pragma unroll
                    for (int m = 0; m < 4; ++m) { const int row = row0 + ai * HALF + m * 16; const f32x4* cs = (const f32x4*)(rope + (size_t)row * 32 + 8 * fq);
                        f32x4 o1[2], o2[2];
#pragma unroll
                        for (int n = 0; n < 2; ++n) { const f32x4 x1 = acc[ai][0][m][n], x2 = acc[ai][1][m][n]; const f32x4 c01 = cs[2 * n], c23 = cs[2 * n + 1];
                            o1[n] = (f32x4){x1[0] * c01[0] - x2[0] * c01[1], x1[1] * c01[2] - x2[1] * c01[3], x1[2] * c23[0] - x2[2] * c23[1], x1[3] * c23[2] - x2[3] * c23[3]};
                            o2[n] = (f32x4){x1[0] * c01[1] + x2[0] * c01[0], x1[1] * c01[3] + x2[1] * c01[2], x1[2] * c23[1] + x2[2] * c23[0], x1[3] * c23[3] + x2[3] * c23[2]}; }
                        *(u32x4*)(KR + (size_t)row * 64 + 8 * fq) = pk8(o1[0], o1[1]); *(u32x4*)(KR + (size_t)row * 64 + 32 + 8 * fq) = pk8(o2[0], o2[1]); }
            }
        } else if (pn < 13 || pn >= 45) {
            bf16_t* dst = (pn < 13 ? ZS + (pn - 5) * 256 : pn < 53 ? SG1 + (pn - 45) * 256 : SG2 + (pn - 53) * 256) + 8 * cg; const bool sl = pn < 13;
#pragma unroll
            for (int ai = 0; ai < 2; ++ai)
#pragma unroll
                for (int m = 0; m < 4; ++m) { const int row = row0 + ai * HALF + m * 16;
#pragma unroll
                    for (int bj = 0; bj < 2; ++bj) { f32x4 v0 = acc[ai][bj][m][0], v1 = acc[ai][bj][m][1];
                        if (sl) { v0 = silu4(v0); v1 = silu4(v1); } else { v0 = sig4(v0); v1 = sig4(v1); }
                        *(u32x4*)(dst + (size_t)row * 2048 + bj * HALF) = pk8(v0, v1); } }
        } else {
            const int ch0 = 64 * (pn - 13) + 4 * cg;
#pragma unroll
            for (int ai = 0; ai < 2; ++ai)
#pragma unroll
                for (int m = 0; m < 4; ++m) { const int row = row0 + ai * HALF + m * 16;
                    const f32x4 uu = acc[ai][1][m][0] * acc[ai][0][m][0], tt = acc[ai][0][m][1] * silu4(acc[ai][1][m][1]);
                    typedef unsigned u32x2v __attribute__((ext_vector_type(2)));
                    u32x2v wu, wt; wu.x = cvt_pk_bf16(uu[0], uu[1]); wu.y = cvt_pk_bf16(uu[2], uu[3]); wt.x = cvt_pk_bf16(tt[0], tt[1]); wt.y = cvt_pk_bf16(tt[2], tt[3]);
                    *(u32x2v*)(U + (size_t)row * 2048 + ch0) = wu; *(u32x2v*)(T + (size_t)row * 2048 + ch0) = wt; }
        }
    }
};
struct EpiQ {
    static constexpr bool PERM = true, AFTER_DRAIN = false;
    bf16_t *QN, *QR; const float* ssq; const float2* rope;
    __device__ __forceinline__ void operator()(const f32x4 (&acc)[2][2][4][2], const Unit& u, int wr, int wc, int fr, int fq) const {
        const int pn = u.pn, row0 = u.pm * BM + wr * 64 + fr, cg = wc * 4 + fq;
#pragma unroll
        for (int ai = 0; ai < 2; ++ai)
#pragma unroll
            for (int m = 0; m < 4; ++m) { const int row = row0 + ai * HALF + m * 16; const float rs = rsqrtf(ssq[row * 2] * (1.f / 512.f) + 1e-6f) * (0.07216878364870322f * 1.4426950408889634f);
                if (pn < 8) {
#pragma unroll
                    for (int bj = 0; bj < 2; ++bj) *(u32x4*)(QN + (size_t)row * 2048 + pn * 256 + bj * HALF + 8 * cg) = pk8(acc[ai][bj][m][0] * rs, acc[ai][bj][m][1] * rs);
                } else { const int head = 4 * (pn - 8) + wc; const f32x4* cs = (const f32x4*)(rope + (size_t)row * 32 + 8 * fq); f32x4 o1[2], o2[2];
#pragma unroll
                    for (int n = 0; n < 2; ++n) { const f32x4 x1 = acc[ai][0][m][n] * rs, x2 = acc[ai][1][m][n] * rs; const f32x4 c01 = cs[2 * n], c23 = cs[2 * n + 1];
                        o1[n] = (f32x4){x1[0] * c01[0] - x2[0] * c01[1], x1[1] * c01[2] - x2[1] * c01[3], x1[2] * c23[0] - x2[2] * c23[1], x1[3] * c23[2] - x2[3] * c23[3]};
                        o2[n] = (f32x4){x1[0] * c01[1] + x2[0] * c01[0], x1[1] * c01[3] + x2[1] * c01[2], x1[2] * c23[1] + x2[2] * c23[0], x1[3] * c23[3] + x2[3] * c23[2]}; }
                    *(u32x4*)(QR + (size_t)row * 1024 + 64 * head + 8 * fq) = pk8(o1[0], o1[1]); *(u32x4*)(QR + (size_t)row * 1024 + 64 * head + 32 + 8 * fq) = pk8(o2[0], o2[1]); }
            }
    }
};
struct EpiKV {
    static constexpr bool PERM = true, AFTER_DRAIN = false;
    bf16_t *KN, *V; const float* ssq;
    __device__ __forceinline__ void operator()(const f32x4 (&acc)[2][2][4][2], const Unit& u, int wr, int wc, int fr, int fq) const {
        const int pn = u.pn, row0 = u.pm * BM + wr * 64 + fr, cg = wc * 4 + fq; bf16_t* dst = (pn < 8 ? KN + pn * 256 : V + (pn - 8) * 256) + 8 * cg;
#pragma unroll
        for (int ai = 0; ai < 2; ++ai)
#pragma unroll
            for (int m = 0; m < 4; ++m) { const int row = row0 + ai * HALF + m * 16; const float rs = rsqrtf(ssq[row * 2 + 1] * (1.f / 512.f) + 1e-6f);
#pragma unroll
                for (int bj = 0; bj < 2; ++bj) *(u32x4*)(dst + (size_t)row * 2048 + bj * HALF) = pk8(acc[ai][bj][m][0] * rs, acc[ai][bj][m][1] * rs); }
    }
};
__device__ __forceinline__ void unpk8(const u32x4& w, f32x4& a, f32x4& b) {
    a = (f32x4){__uint_as_float(w.x << 16), __uint_as_float(w.x & 0xffff0000u), __uint_as_float(w.y << 16), __uint_as_float(w.y & 0xffff0000u)};
    b = (f32x4){__uint_as_float(w.z << 16), __uint_as_float(w.z & 0xffff0000u), __uint_as_float(w.w << 16), __uint_as_float(w.w & 0xffff0000u)}; }
struct EpiY1 {
    static constexpr bool PERM = true, AFTER_DRAIN = false;
    float* tmpf; const bf16_t* sg;
    __device__ __forceinline__ void operator()(const f32x4 (&acc)[2][2][4][2], const Unit& u, int wr, int wc, int fr, int fq) const {
        const int row0 = u.pm * BM + wr * 64 + fr, col0 = u.pn * BM + 8 * (wc * 4 + fq);
#pragma unroll
        for (int ai = 0; ai < 2; ++ai)
#pragma unroll
            for (int m = 0; m < 4; ++m) { const size_t ro = (size_t)(row0 + ai * HALF + m * 16) * 2048 + col0;
#pragma unroll
                for (int bj = 0; bj < 2; ++bj) { f32x4 g0, g1; unpk8(*(const u32x4*)(sg + ro + bj * HALF), g0, g1);
                    *(f32x4*)(tmpf + ro + bj * HALF) = acc[ai][bj][m][0] * g0; *(f32x4*)(tmpf + ro + bj * HALF + 4) = acc[ai][bj][m][1] * g1; } }
    }
};
struct EpiY2 {
    static constexpr bool PERM = true, AFTER_DRAIN = false;
    const float* tmpf; const bf16_t* sg; bf16_t* mg;
    __device__ __forceinline__ void operator()(const f32x4 (&acc)[2][2][4][2], const Unit& u, int wr, int wc, int fr, int fq) const {
        const int row0 = u.pm * BM + wr * 64 + fr, col0 = u.pn * BM + 8 * (wc * 4 + fq);
#pragma unroll
        for (int ai = 0; ai < 2; ++ai)
#pragma unroll
            for (int m = 0; m < 4; ++m) { const size_t ro = (size_t)(row0 + ai * HALF + m * 16) * 2048 + col0;
#pragma unroll
                for (int bj = 0; bj < 2; ++bj) { f32x4 g0, g1; unpk8(*(const u32x4*)(sg + ro + bj * HALF), g0, g1);
                    const f32x4 t0 = *(const f32x4*)(tmpf + ro + bj * HALF), t1 = *(const f32x4*)(tmpf + ro + bj * HALF + 4);
                    *(u32x4*)(mg + ro + bj * HALF) = pk8(t0 + acc[ai][bj][m][0] * g0, t1 + acc[ai][bj][m][1] * g1); } }
    }
};
struct EpiOut {
    static constexpr bool PERM = true, AFTER_DRAIN = false;
    float* outf;
    __device__ __forceinline__ void operator()(const f32x4 (&acc)[2][2][4][2], const Unit& u, int wr, int wc, int fr, int fq) const {
        const int row0 = u.pm * BM + wr * 64 + fr, col0 = u.pn * BM + 8 * (wc * 4 + fq);
#pragma unroll
        for (int ai = 0; ai < 2; ++ai)
#pragma unroll
            for (int m = 0; m < 4; ++m) { const size_t ro = (size_t)(row0 + ai * HALF + m * 16) * 2048 + col0;
#pragma unroll
                for (int bj = 0; bj < 2; ++bj) { *(f32x4*)(outf + ro + bj * HALF) = acc[ai][bj][m][0]; *(f32x4*)(outf + ro + bj * HALF + 4) = acc[ai][bj][m][1]; } }
    }
};

template <class Epi, class Sched, bool ALIGN_EPI = false, bool SP2 = false>
__device__ __forceinline__ void gemm_phase(PG8_LAS unsigned char* lds, const Gemm g, const Sched& S, const Epi& E) {
    const int tid = threadIdx.x, wid = __builtin_amdgcn_readfirstlane(tid >> 6), lane = tid & 63, wr = wid >> 2, wc = wid & 3, fr = lane & 15, fq = lane >> 4;
    const int K = g.K, nt = K / BK;
    unsigned voffA[2], voffB[2];
#pragma unroll
    for (int i = 0; i < 2; ++i) { int R, C; stage_rc(tid * 16 + i * 8192, R, C); const int Rb = Epi::PERM ? ((R & ~31) + perm32(R & 31)) : R;
        voffA[i] = (unsigned)(R * K + C) * 2u; voffB[i] = (unsigned)(Rb * K + C) * 2u; }
    const size_t kstep = (size_t)(BK * 2);
    const size_t hstep = (size_t)HALF * K * 2;
    const size_t tstep = 2 * hstep;
    const unsigned ldsw = (unsigned)wid * 1024u;
    const int aoff = lds_byte(wr * 64 + fr, fq * 8), boff = lds_byte(wc * 32 + fr, fq * 8);
#define PG8_SA(b, h) (((b) * 2 + (h)) * HTB)
#define PG8_SB(b, h) ((4 + (b) * 2 + (h)) * HTB)
#define PG8_STAGE(bufoff, gbase, voff) do { _Pragma("unroll") for (int _i = 0; _i < 2; ++_i) \
        __builtin_amdgcn_global_load_lds((const unsigned*)((const char*)(gbase) + (voff)[_i]), (PG8_LAS unsigned*)(lds + (bufoff) + ldsw + _i * 8192), 16, 0, 0); } while (0)
#define PG8_LDA(dst, b, h) do { _Pragma("unroll") for (int m = 0; m < 4; ++m) _Pragma("unroll") for (int k = 0; k < 2; ++k) dst[m][k] = *(const PG8_LAS bf16x8*)(lds + PG8_SA(b, h) + aoff + m * 2048 + k * 1024); } while (0)
#define PG8_LDB(dst, b, h) do { _Pragma("unroll") for (int n = 0; n < 2; ++n) _Pragma("unroll") for (int k = 0; k < 2; ++k) dst[n][k] = *(const PG8_LAS bf16x8*)(lds + PG8_SB(b, h) + boff + n * 2048 + k * 1024); } while (0)
#define PG8_MMA(ai, bj, At, Bt) do { __builtin_amdgcn_s_setprio(1); _Pragma("unroll") for (int m = 0; m < 4; ++m) _Pragma("unroll") for (int n = 0; n < 2; ++n) _Pragma("unroll") for (int k = 0; k < 2; ++k) \
        acc[ai][bj][m][n] = __builtin_amdgcn_mfma_f32_16x16x32_bf16(Bt[n][k], At[m][k], acc[ai][bj][m][n], 0, 0, 0); __builtin_amdgcn_s_setprio(0); } while (0)
#define PG8_WAIT_V(n) asm volatile("s_waitcnt vmcnt(" #n ")" ::: "memory")
#define PG8_WAIT_L(n) asm volatile("s_waitcnt lgkmcnt(" #n ")" ::: "memory")
#define PG8_BAR __builtin_amdgcn_s_barrier()
#define PG8_SCHED __builtin_amdgcn_sched_barrier(0)
    Unit cur, nxt; int ui = 0;
    if (!S.next(0, cur)) return;
    f32x4 acc[2][2][4][2];
#pragma unroll
    for (int a = 0; a < 2; ++a)
#pragma unroll
        for (int b = 0; b < 2; ++b)
#pragma unroll
            for (int m = 0; m < 4; ++m)
#pragma unroll
                for (int n = 0; n < 2; ++n) acc[a][b][m][n] = (f32x4){0.f, 0.f, 0.f, 0.f};
    bf16x8 At[4][2], B0[2][2], B1[2][2];
    const char* cA = (const char*)g.A + (size_t)cur.pm * tstep; const char* cB = (const char*)g.Bt + (size_t)cur.pn * tstep;
    S.a_ready(cur);
    if constexpr (SP2) {
        PG8_STAGE(PG8_SB(0, 0), cB, voffB); PG8_STAGE(PG8_SB(0, 1), cB + hstep, voffB); PG8_STAGE(PG8_SA(0, 0), cA, voffA); PG8_STAGE(PG8_SA(0, 1), cA + hstep, voffA);
        if (wr == 1) PG8_BAR;
        PG8_WAIT_V(2); PG8_BAR;
        PG8_STAGE(PG8_SB(1, 0), cB + kstep, voffB); PG8_STAGE(PG8_SA(1, 0), cA + kstep, voffA); PG8_STAGE(PG8_SB(1, 1), cB + hstep + kstep, voffB);
        PG8_WAIT_V(6); PG8_BAR;
    } else {
        PG8_STAGE(PG8_SB(0, 0), cB, voffB); PG8_STAGE(PG8_SA(0, 0), cA, voffA); PG8_STAGE(PG8_SB(0, 1), cB + hstep, voffB); PG8_STAGE(PG8_SA(0, 1), cA + hstep, voffA);
        if (wr == 1) PG8_BAR;
        PG8_WAIT_V(4); PG8_BAR;
        PG8_STAGE(PG8_SB(1, 0), cB + kstep, voffB); PG8_STAGE(PG8_SA(1, 0), cA + kstep, voffA); PG8_STAGE(PG8_SB(1, 1), cB + hstep + kstep, voffB);
        PG8_WAIT_V(6); PG8_BAR;
    }
    for (;;) {
        const bool has_next = S.next(ui + 1, nxt);
        const char* nA = has_next ? (const char*)g.A + (size_t)nxt.pm * tstep : cA; const char* nB = has_next ? (const char*)g.Bt + (size_t)nxt.pn * tstep : cB;
        for (int t = 0; t < nt; t += 2) {
            const bool last = (t == nt - 2);
            const char* a1 = cA + (size_t)(t + 1) * kstep;
            const char* a2 = last ? nA : cA + (size_t)(t + 2) * kstep; const char* b2 = last ? nB : cB + (size_t)(t + 2) * kstep;
            const char* a3 = a2 + kstep; const char* b3 = b2 + kstep;
            if (last && has_next) S.a_ready(nxt);
            if constexpr (SP2) {
            PG8_LDB(B0, 0, 0); PG8_LDB(B1, 0, 1); PG8_SCHED; PG8_LDA(At, 0, 0); PG8_STAGE(PG8_SA(1, 1), a1 + hstep, voffA);
            PG8_WAIT_V(8); PG8_WAIT_L(0); PG8_BAR; PG8_MMA(0, 0, At, B0); PG8_MMA(0, 1, At, B1); PG8_BAR; PG8_SCHED;
            PG8_LDA(At, 0, 1); PG8_STAGE(PG8_SB(0, 0), b2, voffB); PG8_STAGE(PG8_SB(0, 1), b2 + hstep, voffB); PG8_STAGE(PG8_SA(0, 0), a2, voffA);
            PG8_WAIT_V(8); PG8_WAIT_L(0); PG8_BAR; PG8_MMA(1, 0, At, B0); PG8_MMA(1, 1, At, B1); PG8_BAR; PG8_SCHED;
            PG8_LDB(B0, 1, 0); PG8_LDB(B1, 1, 1); PG8_SCHED; PG8_LDA(At, 1, 0); PG8_STAGE(PG8_SA(0, 1), a2 + hstep, voffA);
            PG8_WAIT_V(8); PG8_WAIT_L(0); PG8_BAR; PG8_MMA(0, 0, At, B0); PG8_MMA(0, 1, At, B1); PG8_BAR; PG8_SCHED;
            PG8_LDA(At, 1, 1); PG8_STAGE(PG8_SB(1, 0), b3, voffB); PG8_STAGE(PG8_SB(1, 1), b3 + hstep, voffB); PG8_STAGE(PG8_SA(1, 0), a3, voffA);
            PG8_WAIT_V(8); PG8_WAIT_L(0); PG8_BAR; PG8_MMA(1, 0, At, B0); PG8_MMA(1, 1, At, B1); PG8_BAR; PG8_SCHED;
            } else {
            PG8_LDB(B0, 0, 0); PG8_SCHED; PG8_LDA(At, 0, 0); PG8_STAGE(PG8_SA(1, 1), a1 + hstep, voffA);
            PG8_WAIT_L(8); PG8_BAR; PG8_WAIT_L(0); PG8_MMA(0, 0, At, B0); PG8_BAR; PG8_SCHED;
            PG8_LDB(B1, 0, 1); PG8_STAGE(PG8_SB(0, 0), b2, voffB);
            PG8_BAR; PG8_WAIT_L(0); PG8_MMA(0, 1, At, B1); PG8_BAR;
            PG8_LDA(At, 0, 1); PG8_STAGE(PG8_SA(0, 0), a2, voffA);
            PG8_BAR; PG8_WAIT_L(0); PG8_MMA(1, 0, At, B0); PG8_BAR; PG8_SCHED;
            PG8_STAGE(PG8_SB(0, 1), b2 + hstep, voffB);
            PG8_WAIT_V(6); PG8_BAR; PG8_MMA(1, 1, At, B1); PG8_BAR;
            PG8_LDB(B0, 1, 0); PG8_SCHED; PG8_LDA(At, 1, 0); PG8_STAGE(PG8_SA(0, 1), a2 + hstep, voffA);
            PG8_WAIT_L(8); PG8_BAR; PG8_WAIT_L(0); PG8_MMA(0, 0, At, B0); PG8_BAR; PG8_SCHED;
            PG8_LDB(B1, 1, 1); PG8_STAGE(PG8_SB(1, 0), b3, voffB);
            PG8_BAR; PG8_WAIT_L(0); PG8_MMA(0, 1, At, B1); PG8_BAR;
            PG8_LDA(At, 1, 1); PG8_STAGE(PG8_SA(1, 0), a3, voffA);
            PG8_BAR; PG8_WAIT_L(0); PG8_MMA(1, 0, At, B0); PG8_BAR; PG8_SCHED;
            PG8_STAGE(PG8_SB(1, 1), b3 + hstep, voffB);
            PG8_WAIT_V(6); PG8_BAR; PG8_MMA(1, 1, At, B1); PG8_BAR;
            }
        }
        if constexpr (ALIGN_EPI) { if (wr == 0) PG8_BAR; }
        if constexpr (!Epi::AFTER_DRAIN) { E(acc, cur, wr, wc, fr, fq); S.done(cur); }
        if (!has_next) break;
#pragma unroll
        for (int a = 0; a < 2; ++a)
#pragma unroll
            for (int b = 0; b < 2; ++b)
#pragma unroll
                for (int m = 0; m < 4; ++m)
#pragma unroll
                    for (int n = 0; n < 2; ++n) acc[a][b][m][n] = (f32x4){0.f, 0.f, 0.f, 0.f};
        cur = nxt; cA = nA; cB = nB; ++ui;
        if constexpr (ALIGN_EPI) { if (wr == 1) PG8_BAR; }
    }
    PG8_WAIT_V(0);
    if constexpr (!ALIGN_EPI) { if (wr == 0) PG8_BAR; }
    PG8_BAR;
    if constexpr (Epi::AFTER_DRAIN) { E.fused(acc, cur, wr, wc, fr, fq, lds, wid, lane); S.done(cur); }
#undef PG8_SA
#undef PG8_SB
#undef PG8_STAGE
#undef PG8_LDA
#undef PG8_LDB
#undef PG8_MMA
#undef PG8_WAIT_V
#undef PG8_WAIT_L
#undef PG8_BAR
#undef PG8_SCHED
}
}

namespace att {
typedef short bf16x8 __attribute__((ext_vector_type(8)));
typedef short s16x4 __attribute__((ext_vector_type(4)));
typedef float f32x16 __attribute__((ext_vector_type(16)));
typedef float f32x4 __attribute__((ext_vector_type(4)));
typedef unsigned u32x4 __attribute__((ext_vector_type(4)));
constexpr int NW = 8, QBLK = 32, KVBLK = 64, QB = NW * QBLK, NQB = S / QB;
constexpr int SHM_V = KVBLK * 128 * 2, SHM_KN = KVBLK * 128 * 2, SHM_KR = KVBLK * 64 * 2;
constexpr int OFF_V = 0, OFF_KN = 2 * SHM_V, OFF_KR = OFF_KN + 2 * SHM_KN, OFF_WS = OFF_KR + 2 * SHM_KR, OFF_QR = OFF_WS + NW * 64 * 4, LDS_BYTES = OFF_QR + NW * 4096;
constexpr float THR2 = 8.f * 1.4426950408889634f;
#define KSWZ(row, colB) ((row) * 256 + ((colB) ^ (((row) & 7) << 4)))
#define SBAR() __builtin_amdgcn_sched_barrier(0)
__device__ __forceinline__ int kr_off(int row, int ch8) { return (ch8 >> 2) * 4096 + row * 64 + (((ch8 & 3) ^ ((row >> 2) & 3)) << 4); }
__device__ __forceinline__ int v_st(int k, int c) { const int kk = (k & ~0xC) | ((k & 4) << 1) | ((k & 8) >> 1); return ((kk >> 3) * 4 + (c >> 5)) * 512 + ((kk & 7) * 32 + (c & 31)) * 2; }
__device__ __forceinline__ int v_rd_base(int lane) { return ((lane & 3) << 3) | (((lane >> 2) & 3) << 6) | (((lane >> 4) & 1) << 5) | (((lane >> 5) & 1) << 8); }
constexpr int v_rd_off(int d0, int ks, int half) { return d0 * 512 + ks * 4096 + half * 2048; }
__device__ __forceinline__ int crow(int r, int hi) { return (r & 3) + 8 * (r >> 2) + 4 * hi; }
__device__ __forceinline__ unsigned cvtpk(float lo, float hi) { unsigned r; asm volatile("v_cvt_pk_bf16_f32 %0, %1, %2" : "=v"(r) : "v"(lo), "v"(hi)); return r; }
__device__ __forceinline__ void mask_tile(f32x16& p0, f32x16& p1, int dq) {
    const float NEG = -__builtin_inff();
#pragma unroll
    for (int r = 0; r < 16; ++r) { const int c = (r & 3) + 8 * (r >> 2);
        if (dq - c < 0) p0[r] = NEG;
        if (dq - c - 32 < 0) p1[r] = NEG; }
}
__device__ __forceinline__ void partialSM(f32x16& p0, f32x16& p1, float& m_reg, float& mn, float& alpha) {
    float pmax = p0[0];
#pragma unroll
    for (int r = 1; r < 16; ++r) pmax = fmaxf(pmax, p0[r]);
#pragma unroll
    for (int r = 0; r < 16; ++r) pmax = fmaxf(pmax, p1[r]);
    { auto rr = __builtin_amdgcn_permlane32_swap(__float_as_uint(pmax), __float_as_uint(pmax), false, false);
      pmax = fmaxf(__uint_as_float(rr[0]), __uint_as_float(rr[1])); }
    if (__builtin_expect(__all((pmax - m_reg) <= THR2), 1)) { mn = m_reg; alpha = 1.f; }
    else { mn = fmaxf(m_reg, pmax); alpha = __builtin_amdgcn_exp2f(m_reg - mn); m_reg = mn; }
#pragma unroll
    for (int r = 0; r < 16; ++r) p0[r] = p0[r] - mn;
#pragma unroll
    for (int r = 0; r < 16; ++r) p1[r] = p1[r] - mn;
#pragma unroll
    for (int r = 0; r < 16; ++r) p0[r] = __builtin_amdgcn_exp2f(p0[r]);
}
__device__ __forceinline__ void finishSM(f32x16& p0, f32x16& p1, float alpha, float& l_reg, bf16x8& pa0, bf16x8& pa1, bf16x8& pa2, bf16x8& pa3) {
#pragma unroll
    for (int r = 0; r < 16; ++r) p1[r] = __builtin_amdgcn_exp2f(p1[r]);
    float ps = 0;
#pragma unroll
    for (int r = 0; r < 16; ++r) ps += p0[r];
#pragma unroll
    for (int r = 0; r < 16; ++r) ps += p1[r];
    { auto rr = __builtin_amdgcn_permlane32_swap(__float_as_uint(ps), __float_as_uint(ps), false, false);
      ps = __uint_as_float(rr[0]) + __uint_as_float(rr[1]); }
    l_reg = l_reg * alpha + ps;
#define PK4(P, B_, OUT) do { unsigned a0 = cvtpk(P[B_+0], P[B_+1]), a1 = cvtpk(P[B_+2], P[B_+3]);                          \
        unsigned b0 = cvtpk(P[B_+4], P[B_+5]), b1 = cvtpk(P[B_+6], P[B_+7]);                                             \
        auto r0 = __builtin_amdgcn_permlane32_swap(a0, b0, false, false); auto r1 = __builtin_amdgcn_permlane32_swap(a1, b1, false, false); \
        u32x4 w = {r0[0], r1[0], r0[1], r1[1]}; OUT = *reinterpret_cast<bf16x8*>(&w); } while (0)
    PK4(p0, 0, pa0); PK4(p0, 8, pa1); PK4(p1, 0, pa2); PK4(p1, 8, pa3);
#undef PK4
}
template <int KB>
__device__ __forceinline__ void qkt(f32x16& p0, f32x16& p1, const char* lds, int r32, int hi, const bf16x8* qr, const char* ql0, const char* ql1) {
    p0 = f32x16{}; p1 = f32x16{};
    const char* kb[4];
#pragma unroll
    for (int dd = 0; dd < 4; ++dd) kb[dd] = lds + OFF_KN + KB * SHM_KN + KSWZ(r32, (dd * 16 + hi * 8) * 2);
#pragma unroll
    for (int d0 = 0; d0 < 8; ++d0) { const char* a = kb[d0 & 3] + (d0 >> 2) * 128;
        bf16x8 b0 = *reinterpret_cast<const bf16x8*>(a);
        bf16x8 b1 = *reinterpret_cast<const bf16x8*>(a + 32 * 256);
        p0 = __builtin_amdgcn_mfma_f32_32x32x16_bf16(b0, qr[d0], p0, 0, 0, 0);
        p1 = __builtin_amdgcn_mfma_f32_32x32x16_bf16(b1, qr[d0], p1, 0, 0, 0); }
    const char* kr[2];
#pragma unroll
    for (int e = 0; e < 2; ++e) kr[e] = lds + OFF_KR + KB * SHM_KR + kr_off(r32, 2 * e + hi);
#pragma unroll
    for (int d0 = 0; d0 < 4; ++d0) { const char* a = kr[d0 & 1] + (d0 >> 1) * 4096;
        bf16x8 b0 = *reinterpret_cast<const bf16x8*>(a);
        bf16x8 b1 = *reinterpret_cast<const bf16x8*>(a + 32 * 64);
        const bf16x8 qf = *reinterpret_cast<const bf16x8*>(((d0 & 1) ? ql1 : ql0) + (d0 >> 1) * 2048);
        p0 = __builtin_amdgcn_mfma_f32_32x32x16_bf16(b0, qf, p0, 0, 0, 0);
        p1 = __builtin_amdgcn_mfma_f32_32x32x16_bf16(b1, qf, p1, 0, 0, 0); }
}
template <int VB>
__device__ __forceinline__ void pv_tile(f32x16* o, int vb0, bf16x8 pa0, bf16x8 pa1, bf16x8 pa2, bf16x8 pa3) {
#define TRRD(dst, off) asm volatile("ds_read_b64_tr_b16 %0, %1 offset:%2" : "=&v"(dst) : "v"(vb0), "i"(off) : "memory")
#define PV_D0(d0) do { s16x4 l0, l1, l2, l3, h0, h1, h2, h3; constexpr int b_ = OFF_V + VB * SHM_V + v_rd_off(d0, 0, 0);     \
        TRRD(l0, b_); TRRD(h0, b_ + 2048); TRRD(l1, b_ + 4096); TRRD(h1, b_ + 6144); TRRD(l2, b_ + 8192); TRRD(h2, b_ + 10240); TRRD(l3, b_ + 12288); TRRD(h3, b_ + 14336); \
        asm volatile("s_waitcnt lgkmcnt(0)" ::: "memory"); SBAR();   \
        o[d0] = __builtin_amdgcn_mfma_f32_32x32x16_bf16(pa0, (bf16x8){l0[0], l0[1], l0[2], l0[3], h0[0], h0[1], h0[2], h0[3]}, o[d0], 0, 0, 0);   \
        o[d0] = __builtin_amdgcn_mfma_f32_32x32x16_bf16(pa1, (bf16x8){l1[0], l1[1], l1[2], l1[3], h1[0], h1[1], h1[2], h1[3]}, o[d0], 0, 0, 0);   \
        o[d0] = __builtin_amdgcn_mfma_f32_32x32x16_bf16(pa2, (bf16x8){l2[0], l2[1], l2[2], l2[3], h2[0], h2[1], h2[2], h2[3]}, o[d0], 0, 0, 0);   \
        o[d0] = __builtin_amdgcn_mfma_f32_32x32x16_bf16(pa3, (bf16x8){l3[0], l3[1], l3[2], l3[3], h3[0], h3[1], h3[2], h3[3]}, o[d0], 0, 0, 0); } while (0)
    PV_D0(0); PV_D0(1); PV_D0(2); PV_D0(3);
#undef PV_D0
#undef TRRD
}
struct Tens { const bf16_t *QN, *QR, *KN, *KR, *V, *ZS; bf16_t* AO; };
struct BlockRef { int h, P0; };
struct Stage { bf16x8 st_v0, st_v1, st_k0, st_k1, st_kr; };
#define VMW() asm volatile("s_waitcnt vmcnt(0)" ::: "memory")
#define LD8(p) (*reinterpret_cast<const bf16x8*>(p))
#define SLOAD_H(hh, k0) do { const bf16_t* vp_ = T.V + (size_t)((k0) + sr) * 2048 + (hh) * 128 + sc; const bf16_t* kp_ = T.KN + (size_t)((k0) + sr) * 2048 + (hh) * 128 + sc;   \
        G.st_v0 = LD8(vp_); G.st_v1 = LD8(vp_ + 32 * 2048); G.st_k0 = LD8(kp_); G.st_k1 = LD8(kp_ + 32 * 2048); G.st_kr = LD8(T.KR + (size_t)((k0) + krow) * 64 + kch * 8); } while (0)
#define SWRITE_H(bf) do { *(bf16x8*)(lds + OFF_V + (bf) * SHM_V + vst0) = G.st_v0; *(bf16x8*)(lds + OFF_V + (bf) * SHM_V + vst1) = G.st_v1;                          \
        *(bf16x8*)(lds + OFF_KN + (bf) * SHM_KN + kws) = G.st_k0; *(bf16x8*)(lds + OFF_KN + (bf) * SHM_KN + kws + 32 * 256) = G.st_k1; *(bf16x8*)(lds + OFF_KR + (bf) * SHM_KR + krws) = G.st_kr; } while (0)
__device__ __forceinline__ void softmax_tile(f32x16& p0, f32x16& p1, float& m_reg, float& l_reg, float& alpha, bf16x8& pa0, bf16x8& pa1, bf16x8& pa2, bf16x8& pa3) {
    float mn; partialSM(p0, p1, m_reg, mn, alpha);
    finishSM(p0, p1, alpha, l_reg, pa0, pa1, pa2, pa3);
}
__device__ __forceinline__ void attn_block(const Tens& T, const BlockRef& cur, char* lds) {
    const int tid = threadIdx.x, wid = __builtin_amdgcn_readfirstlane(tid >> 6), lane = tid & 63, r32 = lane & 31, hi = lane >> 5;
    const int NT = (cur.P0 + QB) / KVBLK;
    const int qlo = cur.P0 + wid * QBLK, qm = qlo + r32 - 4 * hi;
    float* ws = (float*)(lds + OFF_WS) + wid * 64; float* li_l = ws, * al_l = ws + 32;
    float m_reg = -1e30f, l_reg = 0; f32x16 o[4] = {};
    const int sr = tid >> 4, sc = (tid & 15) * 8, vst0 = v_st(sr, sc), vst1 = v_st(32 + sr, sc), kws = KSWZ(sr, sc * 2), krow = tid >> 3, kch = tid & 7, krws = kr_off(krow, kch);
    const int vb0 = (int)(uintptr_t)(lds) + v_rd_base(lane);
    const int hh = cur.h;
    Stage G; bf16x8 qr[8];
    char* const ql0 = lds + OFF_QR + wid * 4096 + r32 * 64 + (((hi) ^ ((r32 >> 2) & 3)) << 4); char* const ql1 = lds + OFF_QR + wid * 4096 + r32 * 64 + (((2 + hi) ^ ((r32 >> 2) & 3)) << 4);
    SLOAD_H(hh, 0);
    { const size_t qrow_ = (size_t)(cur.P0 + wid * QBLK + r32);
#pragma unroll
      for (int d0 = 0; d0 < 8; ++d0) qr[d0] = LD8(T.QN + qrow_ * 2048 + hh * 128 + d0 * 16 + hi * 8);
      const bf16_t* qp_ = T.QR + qrow_ * 1024 + hh * 64 + hi * 8;
      const bf16x8 t0 = LD8(qp_), t1 = LD8(qp_ + 16), t2 = LD8(qp_ + 32), t3 = LD8(qp_ + 48);
      *(bf16x8*)(ql0) = t0; *(bf16x8*)(ql1) = t1; *(bf16x8*)(ql0 + 2048) = t2; *(bf16x8*)(ql1 + 2048) = t3; }
    VMW(); SWRITE_H(0);
    SLOAD_H(hh, KVBLK);
    f32x16 p0, p1; float alpha; bf16x8 pa0, pa1, pa2, pa3;
#define TILE(t, BF) do {                                                                                                      \
        __syncthreads();                                        \
        if ((t) + 1 < NT) { VMW(); SWRITE_H((BF) ^ 1); }                                                                     \
        if ((t) + 2 < NT) { SLOAD_H(hh, ((t) + 2) * KVBLK); }                                                                \
        SBAR(); qkt<BF>(p0, p1, lds, r32, hi, qr, ql0, ql1);                                                                  \
        { const int kb_ = (t) * KVBLK; if (kb_ + KVBLK - 1 > qlo) mask_tile(p0, p1, qm - kb_); }                              \
        softmax_tile(p0, p1, m_reg, l_reg, alpha, pa0, pa1, pa2, pa3);                                                        \
        if (__any(alpha < 1.f)) { if (hi == 0) al_l[r32] = alpha; asm volatile("s_waitcnt lgkmcnt(0)" ::: "memory");          \
            _Pragma("unroll") for (int d_ = 0; d_ < 4; ++d_) _Pragma("unroll") for (int r = 0; r < 16; ++r) o[d_][r] *= al_l[crow(r, hi)]; }   \
        SBAR(); pv_tile<BF>(o, vb0, pa0, pa1, pa2, pa3); } while (0)
    for (int t = 0; t < NT; t += 2) { TILE(t, 0); TILE(t + 1, 1); }
#undef TILE
    if (hi == 0) li_l[r32] = l_reg; asm volatile("s_waitcnt lgkmcnt(0)" ::: "memory");
    float rli[16];
#pragma unroll
    for (int r = 0; r < 16; ++r) rli[r] = __builtin_amdgcn_rcpf(li_l[crow(r, hi)]);
    const size_t ob = (size_t)(cur.P0 + wid * QBLK) * 2048 + hh * 128;
#pragma unroll
    for (int r = 0; r < 16; ++r) { const int orow = crow(r, hi);
#pragma unroll
        for (int d0 = 0; d0 < 4; ++d0) { const size_t idx = ob + (size_t)orow * 2048 + d0 * 32 + r32;
            const float v = o[d0][r] * rli[r] * bf2f(T.ZS[idx]);
            const float vn = __shfl_xor(v, 1);
            if ((r32 & 1) == 0) *(unsigned*)(T.AO + idx) = cvtpk(v, vn); } }
    __syncthreads();
}
__device__ __forceinline__ BlockRef item_ref(int L, int pass) { const int xc = L & 7, k = L >> 3; BlockRef r; r.h = 2 * xc + (k >> 4); const int x = k & 15; r.P0 = (pass ? 31 - x : x) * QB; return r; }
__device__ __forceinline__ void attn_phase(const Tens& T, char* lds) {
    for (int L = blockIdx.x; L < NH * 16; L += gridDim.x)
        for (int pass = 0; pass < 2; ++pass) attn_block(T, item_ref(L, pass), lds);
}
#undef VMW
#undef LD8
#undef SLOAD_H
#undef SWRITE_H
#undef KSWZ
#undef SBAR
}

#define XB_TMO      128
#define XB_XCNT(j)  (256  + 64 * (j))
#define XB_XSUB(j)  (1280 + 64 * (j))
#define XB_XGEN(j)  (2304 + 64 * (j))
#define XB_TOP      3328
#define XB_TOPGEN   3392
#define XCD_BAR_WORDS 3456
#define XB_SPIN_CAP (1u << 18)

__device__ __forceinline__ unsigned xb_ld(unsigned* p)              { return __hip_atomic_load(p, __ATOMIC_RELAXED, __HIP_MEMORY_SCOPE_AGENT); }
__device__ __forceinline__ unsigned xb_add(unsigned* p, unsigned v) { return __hip_atomic_fetch_add(p, v, __ATOMIC_RELAXED, __HIP_MEMORY_SCOPE_AGENT); }
__device__ __forceinline__ unsigned xb_xcc_id() { return (unsigned)__builtin_amdgcn_s_getreg((3 << 11) | 20) & 0xFu; }
#define XB_SPIN(cond, bar) do { unsigned _sp = 0; while (cond) { __builtin_amdgcn_s_sleep(1); \
    if ((++_sp & 255u) == 0u) { if (xb_ld(&(bar)[XB_TMO])) break; if (_sp > XB_SPIN_CAP) { atomicAdd(&(bar)[XB_TMO], 1u); break; } } } } while (0)

struct XcdBarrier {
    unsigned* bar; unsigned x;
    volatile LAS unsigned* st;
};

__device__ __forceinline__ XcdBarrier xcd_barrier_post(unsigned* bar, volatile LAS unsigned* st) {
    XcdBarrier b; b.bar = bar; b.x = xb_xcc_id(); b.st = st;
    if (threadIdx.x == 0) (void)xb_add(&bar[XB_XCNT(b.x)], 1u);
    return b;
}
__device__ __forceinline__ void xcd_barrier_complete(unsigned* bar, unsigned x, unsigned& nloc, unsigned& nx) {
    const unsigned G = gridDim.x * gridDim.y * gridDim.z;
    unsigned sum, cnt, mine, sp = 0u;
    for (;;) {
        sum = 0u; cnt = 0u; mine = 0u;
#pragma unroll
        for (unsigned j = 0; j < 16; ++j) { const unsigned c = xb_ld(&bar[XB_XCNT(j)]); sum += c; cnt += (c > 0u) ? 1u : 0u; mine = (j == x) ? c : mine; }
        if (sum == G) break;
        __builtin_amdgcn_s_sleep(1);
        if ((++sp & 255u) == 0u) { if (xb_ld(&bar[XB_TMO])) break; if (sp > XB_SPIN_CAP) { atomicAdd(&bar[XB_TMO], 1u); break; } }
    }
    nloc = mine > 0u ? mine : 1u; nx = cnt > 0u ? cnt : 1u;
}

__device__ __forceinline__ void xcd_barrier(const XcdBarrier& b) {
    asm volatile("s_waitcnt vmcnt(0)" ::: "memory");
    __syncthreads();
    if (threadIdx.x == 0) {
        unsigned* bar = b.bar;
        __builtin_amdgcn_s_waitcnt(0);
        unsigned nloc = b.st[0], nx = b.st[1];
        if (nloc == 0u) { xcd_barrier_complete(bar, b.x, nloc, nx); b.st[0] = nloc; b.st[1] = nx; }
        const unsigned old = xb_add(&bar[XB_XSUB(b.x)], 1u);
        const unsigned gen = old / nloc;
        if (old + 1u == (gen + 1u) * nloc) {
            __builtin_amdgcn_fence(__ATOMIC_RELEASE, "agent");
            asm volatile("s_waitcnt vmcnt(0)" ::: "memory");
            const unsigned og = xb_add(&bar[XB_TOP], 1u);
            const unsigned tg = og / nx;
            if (og + 1u == (tg + 1u) * nx) xb_add(&bar[XB_TOPGEN], 1u);
            else XB_SPIN(xb_ld(&bar[XB_TOPGEN]) == tg, bar);
            __builtin_amdgcn_fence(__ATOMIC_ACQUIRE, "agent");
            xb_add(&bar[XB_XGEN(b.x)], 1u);
            asm volatile("s_waitcnt vmcnt(0)" ::: "memory");
        } else {
            XB_SPIN(xb_ld(&bar[XB_XGEN(b.x)]) == gen, bar);
            __builtin_amdgcn_fence(__ATOMIC_ACQUIRE, "agent");
            asm volatile("s_waitcnt vmcnt(0)" ::: "memory");
        }
    }
    __syncthreads();
}

constexpr int NWAVES = 8;
constexpr int RING_OFF = 0, RING_BYTES = 131072;
constexpr int LDSCTL_OFF = RING_BYTES, MISC_OFF = LDSCTL_OFF + 320;
constexpr int LDS_BYTES = 147456;
constexpr int CW_TMO = 0, CW_CODE = 1, CW_BAR = 4096;
constexpr int NPHASE = 8;
#ifndef MK_N_LAUNCHES
#define MK_N_LAUNCHES 1
#endif

typedef float f32x4 __attribute__((ext_vector_type(4)));
#define LDS_WAIT() asm volatile("s_waitcnt lgkmcnt(0)" ::: "memory")
#define VM_WAIT() asm volatile("s_waitcnt vmcnt(0)" ::: "memory")

template <int MAP>
__device__ __forceinline__ void p0_transpose_item(const float* W, int K, int N, int NP, const float* gain, bf16_t* WT, LAS unsigned char* scr, int item, int tid) {
    const int nblk = NP / 256, kb = item / nblk, nb = item % nblk, k0 = 64 * kb, n0 = 256 * nb;
    const int np = tid & 255, kh = (tid >> 8) * 32;
    const int sc = srcmap<MAP>(n0 + np);
    float v[32];
    if (sc >= 0) {
        const GAS float* src = (const GAS float*)W + (size_t)(k0 + kh) * N + sc;
#pragma unroll
        for (int i = 0; i < 32; ++i) v[i] = src[(size_t)i * N];
        if (gain) {
#pragma unroll
            for (int i = 0; i < 32; ++i) v[i] *= gain[k0 + kh + i];
        }
    } else {
#pragma unroll
        for (int i = 0; i < 32; ++i) v[i] = 0.f;
    }
    LAS unsigned* row = (LAS unsigned*)(scr + np * 136 + kh * 2);
#pragma unroll
    for (int i = 0; i < 16; ++i) row[i] = pk2(v[2 * i], v[2 * i + 1]);
    __syncthreads();
#pragma unroll
    for (int p = 0; p < 4; ++p) { const int r = (tid >> 3) + 64 * p, c = tid & 7;
        const LAS unsigned long long* q = (const LAS unsigned long long*)(scr + r * 136 + c * 16);
        const unsigned long long lo = q[0], hi = q[1];
        v4u o; o.x = (unsigned)lo; o.y = (unsigned)(lo >> 32); o.z = (unsigned)hi; o.w = (unsigned)(hi >> 32);
        *(GAS v4u*)(WT + (size_t)(n0 + r) * K + k0 + 8 * c) = o; }
    __syncthreads();
}
struct Args { const float* in[13]; float* out; unsigned char* ws; int ph_lo, ph_hi, li, pad; };

__global__ void __launch_bounds__(NWAVES * 64, 2) mk_fwd(Args args) {
    extern __shared__ __attribute__((aligned(16))) unsigned char lds[];
    LAS unsigned char* ldsp = (LAS unsigned char*)lds;
    volatile LAS unsigned* MISC = (volatile LAS unsigned*)(ldsp + MISC_OFF);
    const int tid = threadIdx.x, lane = tid & 63, wave = __builtin_amdgcn_readfirstlane(tid >> 6);
    const int G = gridDim.x; const int vcu = (G % 8 == 0) ? ((int)blockIdx.x % 8) * (G / 8) + (int)blockIdx.x / 8 : (int)blockIdx.x;
    unsigned char* ws = args.ws;
    unsigned* ctl = (unsigned*)(ws + WS_CTL);
    const float* x = args.in[0]; const int* pos = (const int*)args.in[1]; const float* g_pre = args.in[2]; const float* w_in = args.in[3];
    const float* g_q = args.in[4]; const float* w_qb = args.in[5]; const float* g_kv = args.in[6]; const float* w_kvb = args.in[7];
    const float* conv_w = args.in[8]; const float* w_om = args.in[9]; const float* w_oc = args.in[10]; const float* w_out = args.in[11]; const float* g_post = args.in[12];
    float* ssq = (float*)(ws + WS_SSQ); float2* rope = (float2*)(ws + WS_ROPE);
    bf16_t *WQT = (bf16_t*)(ws + WS_WQT), *WKVT = (bf16_t*)(ws + WS_WKVT), *WOMT = (bf16_t*)(ws + WS_WOMT), *WOCT = (bf16_t*)(ws + WS_WOCT), *WOUTT = (bf16_t*)(ws + WS_WOUTT), *WINT = (bf16_t*)(ws + WS_WINT);
    bf16_t *H = (bf16_t*)(ws + WS_H), *AO = (bf16_t*)(ws + WS_AO), *QA = (bf16_t*)(ws + WS_QA), *CKV = (bf16_t*)(ws + WS_CKV), *KR = (bf16_t*)(ws + WS_KR);
    bf16_t *ZS = (bf16_t*)(ws + WS_ZS), *U = (bf16_t*)(ws + WS_U), *T = (bf16_t*)(ws + WS_T), *SG1 = (bf16_t*)(ws + WS_SG1), *SG2 = (bf16_t*)(ws + WS_SG2);
    bf16_t *QN = (bf16_t*)(ws + WS_QN), *QR = (bf16_t*)(ws + WS_QR), *KN = (bf16_t*)(ws + WS_KN), *V = (bf16_t*)(ws + WS_V), *AC = (bf16_t*)(ws + WS_AC), *MG = (bf16_t*)(ws + WS_MG);
    float* OUTF = (float*)(ws + WS_OUTF);

    for (int u = tid; u < (LDS_BYTES - LDSCTL_OFF) / 4; u += NWAVES * 64) ((LAS unsigned*)(ldsp + LDSCTL_OFF))[u] = 0u;
    __syncthreads();
    const int lo = args.ph_lo, hi = args.ph_hi;
    const bool use_bar = (hi - lo) > 1;
    XcdBarrier bar; bar.bar = ctl + CW_BAR + args.li * XCD_BAR_WORDS; bar.x = 0; bar.st = nullptr;
    if (use_bar) bar = xcd_barrier_post(ctl + CW_BAR + args.li * XCD_BAR_WORDS, MISC + 8);
#ifndef PH_EN
#define PH_EN 0xFF
#endif
#ifndef PROBE_DUP
#define PROBE_DUP -1
#endif
#define REPS(k) for (int rep_ = 0; rep_ < ((PROBE_DUP == (k)) ? 2 : 1); ++rep_)
#define REPBAR(k) do { if (PROBE_DUP == (k) && rep_ == 0) xcd_barrier(bar); } while (0)
#define IN(k) (((PH_EN >> (k)) & 1) && lo <= (k) && (k) < hi)
#define SEAM(k) do { if (lo <= (k) && (k) + 1 < hi) xcd_barrier(bar); } while (0)
    const int gw = vcu * NWAVES + wave, NGW = G * NWAVES;

    if (IN(0)) REPS(0) {
        for (int i = (int)blockIdx.x * (NWAVES * 64) + tid; i < S * 32; i += G * NWAVES * 64) {
            const int s = i >> 5, j = i & 31;
            const float inv = exp2f(-(float)(2 * j) / 64.f * 13.287712379549449f);
            const float ang = (float)pos[s] * inv;
            const double a = (double)ang, kq = rint(a * 0.15915494309189535), r = a - kq * 6.283185307179586;
            const float rf = (float)r;
            rope[i] = make_float2(cosf(rf), sinf(rf));
        }
        for (int m = gw; m < S; m += NGW) {
            const GAS f32x4* xr = (const GAS f32x4*)(x + (size_t)m * DM) + lane;
            f32x4 v[8]; float s = 0.f;
#pragma unroll
            for (int j = 0; j < 8; ++j) { v[j] = xr[64 * j]; s += (v[j].x * v[j].x + v[j].y * v[j].y) + (v[j].z * v[j].z + v[j].w * v[j].w); }
            const float r = rsqrtf(wave_sum(s) * (1.f / DM) + RMS_EPS);
            GAS unsigned long long* o8 = (GAS unsigned long long*)(H + (size_t)m * DM) + lane;
#pragma unroll
            for (int j = 0; j < 8; ++j) { const f32x4 gg = ((const GAS f32x4*)g_pre)[lane + 64 * j];
                o8[64 * j] = (unsigned long long)pk2(v[j].x * r * gg.x, v[j].y * r * gg.y) | ((unsigned long long)pk2(v[j].z * r * gg.z, v[j].w * r * gg.w) << 32); }
        }
        LAS unsigned char* scr = ldsp + RING_OFF;
        constexpr int I_IN = (DM / 64) * (N1P / 256), I_Q = (QL / 64) * (NQ / 256), I_KV = (KVL / 64) * (NKV / 256), I_O = (DM / 64) * (DM / 256);
        constexpr int NITEMS = I_IN + I_Q + I_KV + 3 * I_O;
        for (int it = vcu; it < NITEMS; it += G) {
            int r = it;
            if (r < I_IN) { p0_transpose_item<1>(w_in, DM, IN_TOTAL, N1P, nullptr, WINT, scr, r, tid); continue; } r -= I_IN;
            if (r < I_Q) { p0_transpose_item<2>(w_qb, QL, NQ, NQ, g_q, WQT, scr, r, tid); continue; } r -= I_Q;
            if (r < I_KV) { p0_transpose_item<3>(w_kvb, KVL, NKV, NKV, g_kv, WKVT, scr, r, tid); continue; } r -= I_KV;
            if (r < I_O) { p0_transpose_item<0>(w_om, DM, DM, DM, nullptr, WOMT, scr, r, tid); continue; } r -= I_O;
            if (r < I_O) { p0_transpose_item<0>(w_oc, DM, DM, DM, nullptr, WOCT, scr, r, tid); continue; } r -= I_O;
            p0_transpose_item<0>(w_out, DM, DM, DM, nullptr, WOUTT, scr, r, tid);
        }
        __syncthreads();
        REPBAR(0);
    }
    SEAM(0);
    if (IN(1)) REPS(1) {
        pg8::Gemm g{H, WINT, S, N1P, DM}; pg8::StaticOrder So; So.init(S, N1P, G, (int)blockIdx.x);
        pg8::EpiP1 E{QA, CKV, KR, ZS, U, T, SG1, SG2, ssq, rope};
        pg8::gemm_phase<pg8::EpiP1, pg8::StaticOrder, true, true>(ldsp + RING_OFF, g, So, E);
        REPBAR(1);
    }
    SEAM(1);
    if (IN(2)) REPS(2) {
        { pg8::Gemm g{QA, WQT, S, NQ, QL}; pg8::StaticOrder So; So.init(S, NQ, G, (int)blockIdx.x);
          pg8::EpiQ E{QN, QR, ssq, rope};
          pg8::gemm_phase<pg8::EpiQ, pg8::StaticOrder, true, true>(ldsp + RING_OFF, g, So, E); }
        { pg8::Gemm g{CKV, WKVT, S, NKV, KVL}; pg8::StaticOrder So; So.init(S, NKV, G, (int)blockIdx.x);
          pg8::EpiKV E{KN, V, ssq};
          pg8::gemm_phase<pg8::EpiKV, pg8::StaticOrder, true, true>(ldsp + RING_OFF, g, So, E); }
        for (size_t i = (size_t)blockIdx.x * (NWAVES * 64) + tid; i < (size_t)S * DM / 8; i += (size_t)G * NWAVES * 64) {
            const int s = (int)(i >> 8), c8 = (int)(i & 255) * 8; const size_t e = (size_t)s * DM + c8;
            f32x4 a0, a1, b0, b1, c0, c1, t0, t1;
            { const v4u q_ = *(const GAS v4u*)(U + e); pg8::unpk8(q_, a0, a1); }
            if (s >= 1) { const v4u q_ = *(const GAS v4u*)(U + e - DM); pg8::unpk8(q_, b0, b1); } else { b0 = (f32x4){0.f, 0.f, 0.f, 0.f}; b1 = b0; }
            if (s >= 2) { const v4u q_ = *(const GAS v4u*)(U + e - 2 * DM); pg8::unpk8(q_, c0, c1); } else { c0 = (f32x4){0.f, 0.f, 0.f, 0.f}; c1 = c0; }
            { const v4u q_ = *(const GAS v4u*)(T + e); pg8::unpk8(q_, t0, t1); }
            const f32x4 w00 = *(const GAS f32x4*)(conv_w + c8), w01 = *(const GAS f32x4*)(conv_w + c8 + 4);
            const f32x4 w10 = *(const GAS f32x4*)(conv_w + DM + c8), w11 = *(const GAS f32x4*)(conv_w + DM + c8 + 4);
            const f32x4 w20 = *(const GAS f32x4*)(conv_w + 2 * DM + c8), w21 = *(const GAS f32x4*)(conv_w + 2 * DM + c8 + 4);
            const f32x4 r0 = t0 * (w00 * c0 + w10 * b0 + w20 * a0), r1 = t1 * (w01 * c1 + w11 * b1 + w21 * a1);
            v4u o; o.x = pk2(r0[0], r0[1]); o.y = pk2(r0[2], r0[3]); o.z = pk2(r1[0], r1[1]); o.w = pk2(r1[2], r1[3]);
            *(GAS v4u*)(AC + e) = o;
        }
        REPBAR(2);
    }
    SEAM(2);
    if (IN(3)) REPS(3) {
        att::Tens AT{QN, QR, KN, KR, V, ZS, AO};
        att::attn_phase(AT, (char*)lds + RING_OFF);
        REPBAR(3);
    }
    SEAM(3);
    if (IN(4)) REPS(4) {
        pg8::Gemm g{AO, WOMT, S, DM, DM}; pg8::StaticOrder So; So.init(S, DM, G, (int)blockIdx.x);
        pg8::EpiY1 E{OUTF, SG1};
        pg8::gemm_phase<pg8::EpiY1, pg8::StaticOrder, true, true>(ldsp + RING_OFF, g, So, E);
        REPBAR(4);
    }
    SEAM(4);
    if (IN(5)) REPS(5) {
        pg8::Gemm g{AC, WOCT, S, DM, DM}; pg8::StaticOrder So; So.init(S, DM, G, (int)blockIdx.x);
        pg8::EpiY2 E{OUTF, SG2, MG};
        pg8::gemm_phase<pg8::EpiY2, pg8::StaticOrder, true, true>(ldsp + RING_OFF, g, So, E);
        REPBAR(5);
    }
    SEAM(5);
    if (IN(6)) REPS(6) {
        pg8::Gemm g{MG, WOUTT, S, DM, DM}; pg8::StaticOrder So; So.init(S, DM, G, (int)blockIdx.x);
        pg8::EpiOut E{OUTF};
        pg8::gemm_phase<pg8::EpiOut, pg8::StaticOrder, true, true>(ldsp + RING_OFF, g, So, E);
        REPBAR(6);
    }
    SEAM(6);
    if (IN(7)) REPS(7) {
        for (int m = gw; m < S; m += NGW) {
            const GAS f32x4* yr = (const GAS f32x4*)(OUTF + (size_t)m * DM) + lane; const GAS f32x4* xr = (const GAS f32x4*)(x + (size_t)m * DM) + lane;
            f32x4 v[8]; float s = 0.f;
#pragma unroll
            for (int j = 0; j < 8; ++j) { v[j] = yr[64 * j]; s += (v[j].x * v[j].x + v[j].y * v[j].y) + (v[j].z * v[j].z + v[j].w * v[j].w); }
            const float r = rsqrtf(wave_sum(s) * (1.f / DM) + RMS_EPS);
            GAS f32x4* orow = (GAS f32x4*)(args.out + (size_t)m * DM) + lane;
#pragma unroll
            for (int j = 0; j < 8; ++j) { const f32x4 gg = ((const GAS f32x4*)g_post)[lane + 64 * j]; orow[64 * j] = xr[64 * j] + v[j] * r * gg; }
        }
        REPBAR(7);
    }
#undef IN
#undef SEAM
}

__global__ void __launch_bounds__(256) k_prep_misc(const int* pos, float2* rope, float* ssq) {
    const int i = blockIdx.x * 256 + threadIdx.x;
    if (i < S * 32) {
        const int s = i >> 5, j = i & 31;
        const float inv = exp2f(-(float)(2 * j) / 64.f * 13.287712379549449f);
        const float ang = (float)pos[s] * inv;
        const double a = (double)ang;
        const double k = rint(a * 0.15915494309189535);
        const double r = a - k * 6.283185307179586;
        const float rf = (float)r;
        rope[i] = make_float2(cosf(rf), sinf(rf));
    }
    if (i < S * 2) ssq[i] = 0.f;
}
__global__ void __launch_bounds__(256) k_xnorm(const float* x, const float* g, bf16_t* H) {
    const int row = blockIdx.x * 4 + (threadIdx.x >> 6), lane = threadIdx.x & 63;
    const float4* xr = (const float4*)(x + (size_t)row * DM);
    float4 v[8]; float s = 0.f;
#pragma unroll
    for (int j = 0; j < 8; ++j) { v[j] = xr[lane + 64 * j]; s += v[j].x * v[j].x + v[j].y * v[j].y + v[j].z * v[j].z + v[j].w * v[j].w; }
    const float r = rsqrtf(wave_sum(s) * (1.f / DM) + RMS_EPS);
#pragma unroll
    for (int j = 0; j < 8; ++j) {
        const float4 gg = ((const float4*)g)[lane + 64 * j];
        ushort4 o; o.x = f2bf(v[j].x * r * gg.x); o.y = f2bf(v[j].y * r * gg.y); o.z = f2bf(v[j].z * r * gg.z); o.w = f2bf(v[j].w * r * gg.w);
        ((ushort4*)(H + (size_t)row * DM))[lane + 64 * j] = o;
    }
}

template <int ND, class F>
__global__ void __launch_bounds__(256) nv_dots(F f) {
    const int c = blockIdx.x * 256 + threadIdx.x, r0 = blockIdx.y * 8;
    const bool act = c < f.ncols; const int cc = act ? c : 0;
    float acc[ND][8];
#pragma unroll
    for (int d = 0; d < ND; ++d)
#pragma unroll
        for (int i = 0; i < 8; ++i) acc[d][i] = 0.f;
    int wc[ND];
#pragma unroll
    for (int d = 0; d < ND; ++d) wc[d] = f.wcol(d, cc);
    for (int k = 0; k < f.K; k += 8) {
        float a[8][8];
#pragma unroll
        for (int i = 0; i < 8; ++i) {
            const v4u q = *(const v4u*)(f.A + (size_t)(r0 + i) * f.lda + k);
#pragma unroll
            for (int e = 0; e < 4; ++e) { a[i][2 * e] = __uint_as_float(q[e] << 16); a[i][2 * e + 1] = __uint_as_float(q[e] & 0xffff0000u); }
        }
#pragma unroll
        for (int e = 0; e < 8; ++e) {
            const float gk = f.gain ? f.gain[k + e] : 1.f;
#pragma unroll
            for (int d = 0; d < ND; ++d) {
                const float w = f.W[(size_t)(k + e) * f.ldw + wc[d]] * gk;
#pragma unroll
                for (int i = 0; i < 8; ++i) acc[d][i] = fmaf(a[i][e], w, acc[d][i]);
            }
        }
    }
#pragma unroll
    for (int i = 0; i < 8; ++i) { float v[ND];
#pragma unroll
        for (int d = 0; d < ND; ++d) v[d] = acc[d][i];
        f.out(r0 + i, cc, v, act); }
}
struct FBase { const bf16_t* A; int lda; const float* W; int ldw; const float* gain; int K; int ncols; };
struct F_LAT : FBase { int cbase; bf16_t* dst; float* ssq; int which;
    __device__ int wcol(int, int c) const { return cbase + c; }
    __device__ void out(int row, int c, const float (&v)[1], bool) const { dst[(size_t)row * 512 + c] = f2bf(v[0]); const float s = wave_sum(v[0] * v[0]); if ((threadIdx.x & 63) == 0) atomicAdd(ssq + row * 2 + which, s); } };
struct F_KR : FBase { bf16_t* dst; const float2* rope;
    __device__ int wcol(int d, int c) const { return C_KR + 32 * d + c; }
    __device__ void out(int row, int c, const float (&v)[2], bool act) const { if (!act) return; const float2 cs = rope[row * 32 + c];
        dst[(size_t)row * 64 + c] = f2bf(v[0] * cs.x - v[1] * cs.y); dst[(size_t)row * 64 + 32 + c] = f2bf(v[0] * cs.y + v[1] * cs.x); } };
struct F_ACT : FBase { int cbase; bf16_t* dst; int mode;
    __device__ int wcol(int, int c) const { return cbase + c; }
    __device__ void out(int row, int c, const float (&v)[1], bool) const { dst[(size_t)row * DM + c] = f2bf(mode == 0 ? silu_f(v[0]) : sigm_f(v[0])); } };
struct F_CV : FBase { bf16_t* U; bf16_t* T;
    __device__ int wcol(int d, int c) const { return (d == 0 ? C_CIN : d == 1 ? C_BG : d == 2 ? C_CG : C_ZC) + c; }
    __device__ void out(int row, int c, const float (&v)[4], bool) const { U[(size_t)row * DM + c] = f2bf(v[2] * v[0]); T[(size_t)row * DM + c] = f2bf(v[1] * silu_f(v[3])); } };
struct F_QN : FBase { bf16_t* dst; const float* ssq;
    __device__ int wcol(int, int c) const { return 192 * (c >> 7) + (c & 127); }
    __device__ void out(int row, int c, const float (&v)[1], bool) const { const float r = rsqrtf(ssq[row * 2] * (1.f / QL) + RMS_EPS); dst[(size_t)row * 2048 + c] = f2bf(v[0] * r * QSCALE); } };
struct F_QR : FBase { bf16_t* dst; const float* ssq; const float2* rope;
    __device__ int wcol(int d, int c) const { return 192 * (c >> 5) + 128 + 32 * d + (c & 31); }
    __device__ void out(int row, int c, const float (&v)[2], bool) const { const float r = rsqrtf(ssq[row * 2] * (1.f / QL) + RMS_EPS) * QSCALE; const float2 cs = rope[row * 32 + (c & 31)];
        const int h = c >> 5, i = c & 31; const float x1 = v[0] * r, x2 = v[1] * r;
        dst[(size_t)row * 1024 + 64 * h + i] = f2bf(x1 * cs.x - x2 * cs.y); dst[(size_t)row * 1024 + 64 * h + 32 + i] = f2bf(x1 * cs.y + x2 * cs.x); } };
struct F_KV : FBase { bf16_t* dst; const float* ssq; int off;
    __device__ int wcol(int, int c) const { return 256 * (c >> 7) + off + (c & 127); }
    __device__ void out(int row, int c, const float (&v)[1], bool) const { const float r = rsqrtf(ssq[row * 2 + 1] * (1.f / KVL) + RMS_EPS); dst[(size_t)row * 2048 + c] = f2bf(v[0] * r); } };
struct F_Y1 : FBase { float* tmp; const bf16_t* sg;
    __device__ int wcol(int, int c) const { return c; }
    __device__ void out(int row, int c, const float (&v)[1], bool) const { tmp[(size_t)row * DM + c] = v[0] * bf2f(sg[(size_t)row * DM + c]); } };
struct F_Y2 : FBase { const float* tmp; const bf16_t* sg; bf16_t* mg;
    __device__ int wcol(int, int c) const { return c; }
    __device__ void out(int row, int c, const float (&v)[1], bool) const { mg[(size_t)row * DM + c] = f2bf(tmp[(size_t)row * DM + c] + v[0] * bf2f(sg[(size_t)row * DM + c])); } };
struct F_OUT : FBase { float* outf;
    __device__ int wcol(int, int c) const { return c; }
    __device__ void out(int row, int c, const float (&v)[1], bool) const { outf[(size_t)row * DM + c] = v[0]; } };

__global__ void __launch_bounds__(256) k_conv(const bf16_t* U, const bf16_t* T, const float* cw, bf16_t* AC) {
    const size_t i = (size_t)blockIdx.x * 256 + threadIdx.x;
    const int s = (int)(i / DM), c = (int)(i % DM);
    const float u0 = bf2f(U[i]), u1 = s >= 1 ? bf2f(U[i - DM]) : 0.f, u2 = s >= 2 ? bf2f(U[i - 2 * DM]) : 0.f;
    const float cv = cw[c] * u2 + cw[DM + c] * u1 + cw[2 * DM + c] * u0;
    AC[i] = f2bf(bf2f(T[i]) * cv);
}

constexpr int NA_LDS = (64 * 193 * 2 + 64 * 132 + 64 * 65) * 4;
__global__ void __launch_bounds__(256) nv_attn(const bf16_t* QN, const bf16_t* QR, const bf16_t* KN, const bf16_t* KR, const bf16_t* V, const bf16_t* ZS, bf16_t* AO) {
    extern __shared__ __attribute__((aligned(16))) float sm[];
    float* Qs = sm; float* Ks = Qs + 64 * 193; float* Vs = Ks + 64 * 193; float* Ps = Vs + 64 * 132;
    const int qb = blockIdx.x, h = blockIdx.y, tid = threadIdx.x, r = tid >> 2, qq = tid & 3, q0 = qb * 64;
    for (int i = tid; i < 64 * 192; i += 256) { const int rr = i / 192, d = i % 192;
        Qs[rr * 193 + d] = d < 128 ? bf2f(QN[(size_t)(q0 + rr) * 2048 + h * 128 + d]) : bf2f(QR[(size_t)(q0 + rr) * 1024 + h * 64 + d - 128]); }
    float m = -1e30f, l = 0.f, o[32];
#pragma unroll
    for (int d = 0; d < 32; ++d) o[d] = 0.f;
    for (int kt = 0; kt <= qb; ++kt) {
        __syncthreads();
        const int k0 = kt * 64;
        for (int i = tid; i < 64 * 192; i += 256) { const int rr = i / 192, d = i % 192;
            Ks[rr * 193 + d] = d < 128 ? bf2f(KN[(size_t)(k0 + rr) * 2048 + h * 128 + d]) : bf2f(KR[(size_t)(k0 + rr) * 64 + d - 128]); }
        for (int i = tid; i < 64 * 128; i += 256) { const int rr = i >> 7, d = i & 127; Vs[rr * 132 + (d >> 5) * 33 + (d & 31)] = bf2f(V[(size_t)(k0 + rr) * 2048 + h * 128 + d]); }
        __syncthreads();
        float s[16]; float mx = -INFINITY;
#pragma unroll
        for (int j = 0; j < 16; ++j) { const int key = 4 * j + qq; float a = 0.f;
            for (int d = 0; d < 192; ++d) a = fmaf(Qs[r * 193 + d], Ks[key * 193 + d], a);
            if (k0 + key > q0 + r) a = -INFINITY;
            s[j] = a; mx = fmaxf(mx, a); }
        mx = fmaxf(mx, __shfl_xor(mx, 1)); mx = fmaxf(mx, __shfl_xor(mx, 2));
        const float mn = fmaxf(m, mx), alpha = exp2f(m - mn); m = mn;
        float ps = 0.f;
#pragma unroll
        for (int j = 0; j < 16; ++j) { const float p = exp2f(s[j] - mn); ps += p; Ps[r * 65 + 4 * j + qq] = p; }
        ps += __shfl_xor(ps, 1); ps += __shfl_xor(ps, 2);
        l = l * alpha + ps;
        __syncthreads();
#pragma unroll
        for (int d = 0; d < 32; ++d) o[d] *= alpha;
        for (int key = 0; key < 64; ++key) { const float p = Ps[r * 65 + key];
#pragma unroll
            for (int d = 0; d < 32; ++d) o[d] = fmaf(p, Vs[key * 132 + qq * 33 + d], o[d]); }
    }
    const float li = 1.f / l;
#pragma unroll
    for (int d = 0; d < 32; ++d) { const size_t idx = (size_t)(q0 + r) * 2048 + h * 128 + qq * 32 + d; AO[idx] = f2bf(o[d] * li * bf2f(ZS[idx])); }
}

__global__ void __launch_bounds__(256) k_final(const float* x, const float* outf, const float* g, float* out) {
    const int row = blockIdx.x * 4 + (threadIdx.x >> 6), lane = threadIdx.x & 63;
    const float4* yr = (const float4*)(outf + (size_t)row * DM); const float4* xr = (const float4*)(x + (size_t)row * DM);
    float4 v[8]; float s = 0.f;
#pragma unroll
    for (int j = 0; j < 8; ++j) { v[j] = yr[lane + 64 * j]; s += v[j].x * v[j].x + v[j].y * v[j].y + v[j].z * v[j].z + v[j].w * v[j].w; }
    const float r = rsqrtf(wave_sum(s) * (1.f / DM) + RMS_EPS);
#pragma unroll
    for (int j = 0; j < 8; ++j) { const float4 gg = ((const float4*)g)[lane + 64 * j], xx = xr[lane + 64 * j];
        float4 o; o.x = xx.x + v[j].x * r * gg.x; o.y = xx.y + v[j].y * r * gg.y; o.z = xx.z + v[j].z * r * gg.z; o.w = xx.w + v[j].w * r * gg.w;
        ((float4*)(out + (size_t)row * DM))[lane + 64 * j] = o; }
}


template <int ND, class F> static void run_dots(const F& f, hipStream_t st) {
    hipLaunchKernelGGL((nv_dots<ND, F>), dim3((f.ncols + 255) / 256, S / 8), dim3(256), 0, st, f);
}
#ifndef IMPL_MASK
#define IMPL_MASK 0xFF
#endif
extern "C" void kernel_launch(void* const* d_in, const int* in_sizes, int n_in, void* d_out, int out_size, void* d_ws, size_t ws_size, hipStream_t stream) {
    static int grid = 0;
    if (grid == 0) {
        if (n_in != 13 || in_sizes[0] != S * DM || in_sizes[3] != DM * IN_TOTAL || out_size != S * DM || ws_size < WS_END) {
            fprintf(stderr, "kernel_launch: unexpected shapes / workspace (n_in %d, ws %zu, need %zu)\n", n_in, ws_size, (size_t)WS_END); grid = -1; return; }
        int dev = 0, cus = 0, per_cu = 0;
        if (hipGetDevice(&dev) != hipSuccess || hipDeviceGetAttribute(&cus, hipDeviceAttributeMultiprocessorCount, dev) != hipSuccess) { grid = -1; return; }
        if (hipFuncSetAttribute((const void*)mk_fwd, hipFuncAttributeMaxDynamicSharedMemorySize, LDS_BYTES) != hipSuccess) { fprintf(stderr, "kernel_launch: hipFuncSetAttribute failed\n"); grid = -1; return; }
        (void)hipFuncSetAttribute((const void*)nv_attn, hipFuncAttributeMaxDynamicSharedMemorySize, NA_LDS);
        if (hipOccupancyMaxActiveBlocksPerMultiprocessor(&per_cu, (const void*)mk_fwd, NWAVES * 64, LDS_BYTES) != hipSuccess || per_cu < 1) { fprintf(stderr, "kernel_launch: occupancy query says %d\n", per_cu); per_cu = 1; }
        (void)hipGetLastError();
        grid = cus * 1;
        if (per_cu < 1) grid = -1;
    }
    if (grid < 0) return;
    if (hipMemsetAsync((char*)d_ws + WS_CTL, 0, CTL_ZERO_BYTES, stream) != hipSuccess) { fprintf(stderr, "kernel_launch: memset failed\n"); return; }
    Args a; memset(&a, 0, sizeof a);
    for (int i = 0; i < 13; ++i) a.in[i] = (const float*)d_in[i];
    a.out = (float*)d_out; a.ws = (unsigned char*)d_ws;
    if (MK_N_LAUNCHES == 1 && (IMPL_MASK & 0xFF) == 0xFF) {
        a.ph_lo = 0; a.ph_hi = NPHASE; a.li = 0;
        void* kargs[] = {&a};
        hipError_t e = hipLaunchCooperativeKernel((const void*)mk_fwd, dim3(grid), dim3(NWAVES * 64), kargs, LDS_BYTES, stream);
        if (e != hipSuccess) fprintf(stderr, "kernel_launch: cooperative launch failed: %s (grid %d)\n", hipGetErrorString(e), grid);
        return;
    }
    const float* x = (const float*)d_in[0]; const int* pos = (const int*)d_in[1]; const float* g_pre = (const float*)d_in[2]; const float* w_in = (const float*)d_in[3];
    const float* g_q = (const float*)d_in[4]; const float* w_qb = (const float*)d_in[5]; const float* g_kv = (const float*)d_in[6]; const float* w_kvb = (const float*)d_in[7];
    const float* conv_w = (const float*)d_in[8]; const float* w_om = (const float*)d_in[9]; const float* w_oc = (const float*)d_in[10]; const float* w_out = (const float*)d_in[11];
    const float* g_post = (const float*)d_in[12];
    unsigned char* ws = (unsigned char*)d_ws;
    float* ssq = (float*)(ws + WS_SSQ); float2* rope = (float2*)(ws + WS_ROPE);
    bf16_t *H = (bf16_t*)(ws + WS_H), *AO = (bf16_t*)(ws + WS_AO), *QA = (bf16_t*)(ws + WS_QA), *CKV = (bf16_t*)(ws + WS_CKV), *KR = (bf16_t*)(ws + WS_KR);
    bf16_t *ZS = (bf16_t*)(ws + WS_ZS), *U = (bf16_t*)(ws + WS_U), *T = (bf16_t*)(ws + WS_T), *SG1 = (bf16_t*)(ws + WS_SG1), *SG2 = (bf16_t*)(ws + WS_SG2);
    bf16_t *QN = (bf16_t*)(ws + WS_QN), *QR = (bf16_t*)(ws + WS_QR), *KN = (bf16_t*)(ws + WS_KN), *V = (bf16_t*)(ws + WS_V), *AC = (bf16_t*)(ws + WS_AC), *MG = (bf16_t*)(ws + WS_MG);
    float* OUTF = (float*)(ws + WS_OUTF);
    for (int k = 0; k < NPHASE; ++k) {
        if ((IMPL_MASK >> k) & 1) { a.ph_lo = k; a.ph_hi = k + 1; a.li = 0; hipLaunchKernelGGL(mk_fwd, dim3(grid), dim3(NWAVES * 64), LDS_BYTES, stream, a); continue; }
        switch (k) {
        case 0: hipLaunchKernelGGL(k_prep_misc, dim3(S * 32 / 256), dim3(256), 0, stream, pos, rope, ssq + S * 2);
                hipLaunchKernelGGL(k_xnorm, dim3(S / 4), dim3(256), 0, stream, x, g_pre, H); break;
        case 1: { { F_LAT f; memset(&f, 0, sizeof f); f.A = H; f.lda = DM; f.W = w_in; f.ldw = IN_TOTAL; f.gain = nullptr; f.K = DM; f.ncols = 512; f.cbase = C_QA; f.dst = QA; f.ssq = ssq; f.which = 0; run_dots<1>(f, stream);
                    f.cbase = C_CKV; f.dst = CKV; f.which = 1; run_dots<1>(f, stream); }
                  { F_KR f; memset(&f, 0, sizeof f); f.A = H; f.lda = DM; f.W = w_in; f.ldw = IN_TOTAL; f.gain = nullptr; f.K = DM; f.ncols = 32; f.dst = KR; f.rope = rope; run_dots<2>(f, stream); }
                  { F_ACT f; memset(&f, 0, sizeof f); f.A = H; f.lda = DM; f.W = w_in; f.ldw = IN_TOTAL; f.gain = nullptr; f.K = DM; f.ncols = DM; f.cbase = C_ZM; f.dst = ZS; f.mode = 0; run_dots<1>(f, stream);
                    f.cbase = C_GM; f.dst = SG1; f.mode = 1; run_dots<1>(f, stream);
                    f.cbase = C_GC; f.dst = SG2; f.mode = 1; run_dots<1>(f, stream); }
                  { F_CV f; memset(&f, 0, sizeof f); f.A = H; f.lda = DM; f.W = w_in; f.ldw = IN_TOTAL; f.gain = nullptr; f.K = DM; f.ncols = DM; f.U = U; f.T = T; run_dots<4>(f, stream); } } break;
        case 2: { { F_QN f; memset(&f, 0, sizeof f); f.A = QA; f.lda = QL; f.W = w_qb; f.ldw = 3072; f.gain = g_q; f.K = QL; f.ncols = 2048; f.dst = QN; f.ssq = ssq; run_dots<1>(f, stream); }
                  { F_QR f; memset(&f, 0, sizeof f); f.A = QA; f.lda = QL; f.W = w_qb; f.ldw = 3072; f.gain = g_q; f.K = QL; f.ncols = 512; f.dst = QR; f.ssq = ssq; f.rope = rope; run_dots<2>(f, stream); }
                  { F_KV f; memset(&f, 0, sizeof f); f.A = CKV; f.lda = KVL; f.W = w_kvb; f.ldw = 4096; f.gain = g_kv; f.K = KVL; f.ncols = 2048; f.dst = KN; f.ssq = ssq; f.off = 0; run_dots<1>(f, stream);
                    f.dst = V; f.off = 128; run_dots<1>(f, stream); }
                  hipLaunchKernelGGL(k_conv, dim3(S * DM / 256), dim3(256), 0, stream, U, T, conv_w, AC); } break;
        case 3: hipLaunchKernelGGL(nv_attn, dim3(S / 64, NH), dim3(256), NA_LDS, stream, QN, QR, KN, KR, V, ZS, AO); break;
        case 4: { F_Y1 f; memset(&f, 0, sizeof f); f.A = AO; f.lda = DM; f.W = w_om; f.ldw = DM; f.gain = nullptr; f.K = DM; f.ncols = DM; f.tmp = OUTF; f.sg = SG1; run_dots<1>(f, stream); } break;
        case 5: { F_Y2 f; memset(&f, 0, sizeof f); f.A = AC; f.lda = DM; f.W = w_oc; f.ldw = DM; f.gain = nullptr; f.K = DM; f.ncols = DM; f.tmp = OUTF; f.sg = SG2; f.mg = MG; run_dots<1>(f, stream); } break;
        case 6: { F_OUT f; memset(&f, 0, sizeof f); f.A = MG; f.lda = DM; f.W = w_out; f.ldw = DM; f.gain = nullptr; f.K = DM; f.ncols = DM; f.outf = OUTF; run_dots<1>(f, stream); } break;
        default: hipLaunchKernelGGL(k_final, dim3(S / 4), dim3(256), 0, stream, x, OUTF, g_post, (float*)d_out); break;
        }
    }
}
```

```cpp
#define MK_N_LAUNCHES 1
#include <hip/hip_runtime.h>
#include <cstdio>
#include <cstdint>
#include <cstring>

constexpr int S = 8192, DM = 2048, NH = 16, QL = 512, KVL = 512;
constexpr int IN_TOTAL = 15424;
constexpr int C_QA = 0, C_CKV = 512, C_KR = 1024, C_ZM = 1088, C_CIN = 3136, C_BG = 5184, C_CG = 7232, C_ZC = 9280, C_GM = 11328, C_GC = 13376;
constexpr int N1P = 61 * 256;
constexpr int NQ = 3072, NKV = 4096;
constexpr float RMS_EPS = 1e-6f;
constexpr float QSCALE = 0.07216878364870322f * 1.4426950408889634f;

constexpr size_t MiB = 1u << 20;
constexpr size_t WS_CTL = 0, CTL_ZERO_BYTES = 1 * MiB;
constexpr size_t WS_SSQ = 512 * 1024;
constexpr size_t WS_ROPE = 2 * MiB;
constexpr size_t WS_WQT = 4 * MiB, WS_WKVT = 7 * MiB, WS_WOMT = 11 * MiB, WS_WOCT = 19 * MiB, WS_WOUTT = 27 * MiB, WS_WINT = 35 * MiB;
constexpr size_t WS_H = 96 * MiB;
constexpr size_t WS_AO = WS_H;
constexpr size_t WS_QA = 128 * MiB, WS_CKV = 136 * MiB, WS_KR = 144 * MiB;
constexpr size_t WS_ZS = 146 * MiB, WS_U = 178 * MiB, WS_T = 210 * MiB, WS_SG1 = 242 * MiB, WS_SG2 = 274 * MiB;
constexpr size_t WS_QN = 306 * MiB, WS_QR = 338 * MiB, WS_KN = 354 * MiB, WS_V = 386 * MiB;
constexpr size_t WS_AC = 418 * MiB, WS_END = 450 * MiB;
constexpr size_t WS_MG = WS_U;
constexpr size_t WS_OUTF = WS_QN;
static_assert(WS_WINT + (size_t)N1P * DM * 2 <= WS_H, "ws map");

typedef unsigned short bf16_t;
typedef unsigned v4u __attribute__((ext_vector_type(4)));
#define GAS __attribute__((address_space(1)))
#define LAS __attribute__((address_space(3)))
__device__ __forceinline__ float bf2f(bf16_t v) { return __uint_as_float((unsigned)v << 16); }
__device__ __forceinline__ bf16_t f2bf(float f) { unsigned u = __float_as_uint(f); return (bf16_t)((u + 0x7fffu + ((u >> 16) & 1u)) >> 16); }
__device__ __forceinline__ unsigned pk2(float lo, float hi) { return (unsigned)f2bf(lo) | ((unsigned)f2bf(hi) << 16); }
__device__ __forceinline__ float silu_f(float v) { return v / (1.f + expf(-v)); }
__device__ __forceinline__ float sigm_f(float v) { return 1.f / (1.f + expf(-v)); }
__device__ __forceinline__ float fsigm(float v) { return __builtin_amdgcn_rcpf(1.f + __builtin_amdgcn_exp2f(-1.4426950408889634f * v)); }
__device__ __forceinline__ float wave_sum(float v) {
#pragma unroll
    for (int o = 1; o < 64; o <<= 1) v += __shfl_xor(v, o);
    return v;
}
template <int MAP> __device__ __forceinline__ int srcmap(int np) {
    if (MAP == 1) {
        const int t = np >> 8, c = np & 255;
        if (t < 4) return np;
        if (t == 4) return (c & 127) < 32 ? C_KR + 32 * (c >> 7) + (c & 127) : -1;
        if (t < 13) return C_ZM + np - 5 * 256;
        if (t < 45) { const int tt = t - 13, kind = 2 * (c >> 7) + ((c >> 2) & 1), ch = 64 * tt + 4 * ((c & 127) >> 3) + (c & 3);
            return (kind == 0 ? C_CIN : kind == 1 ? C_BG : kind == 2 ? C_CG : C_ZC) + ch; }
        if (t < 53) return C_GM + np - 45 * 256;
        return C_GC + np - 53 * 256;
    }
    if (MAP == 2) {
        if (np < 2048) return 192 * (np >> 7) + (np & 127);
        const int t = (np - 2048) >> 8, c = np & 255, head = 4 * t + ((c & 127) >> 5);
        return 192 * head + 128 + 32 * (c >> 7) + (c & 31);
    }
    if (MAP == 3) { const int h = (np & 2047) >> 7, d = np & 127; return 256 * h + (np >= 2048 ? 128 : 0) + d; }
    return np;
}

namespace pg8 {
#define PG8_LAS __attribute__((address_space(3)))
typedef unsigned short bf16_t;
typedef short bf16x8 __attribute__((ext_vector_type(8)));
typedef float f32x4 __attribute__((ext_vector_type(4)));
typedef unsigned u32x4 __attribute__((ext_vector_type(4)));
constexpr int BM = 256, BK = 64, HALF = 128, HTB = HALF * BK * 2  , STAGE_BYTES = 8 * HTB, NXCD = 8, WGM = 8;

__host__ __device__ __forceinline__ int lds_byte(int r, int c) { const int st = (r >> 4) * 2 + (c >> 5), rr = r & 15, cc = c & 31, ob = rr * 64 + cc * 2; return st * 1024 + (ob ^ (((ob >> 9) & 1) << 5)); }
__host__ __device__ __forceinline__ void stage_rc(int b, int& R, int& C) { const int st = b / 1024, sb = b % 1024, swz = sb ^ (((sb >> 9) & 1) << 5); R = (st >> 1) * 16 + swz / 64; C = (st & 1) * 32 + (swz % 64) / 2; }
__host__ __device__ __forceinline__ int perm32(int rho) { const int n = rho >> 4, i = rho & 15; return 8 * (i >> 2) + 4 * n + (i & 3); }

struct Unit { int pm, pn; };
struct Gemm { const bf16_t* A; const bf16_t* Bt; int M, N, K; const bf16_t* A2; const bf16_t* Bt2; };

struct StaticOrder {
    int nM, nN, nwg, G, c;
    __host__ __device__ void init(int M, int N, int G_, int c_) { nM = M / BM; nN = N / BM; nwg = nM * nN; G = G_; c = c_; }
    __host__ __device__ bool next(int i, Unit& u) const {
        const long L = (long)i * G + c; if (L >= nwg) return false;
        int wgid = (int)L; { const int q = nwg / NXCD, r = nwg % NXCD, xcd = wgid % NXCD, off = wgid / NXCD; wgid = (xcd < r ? xcd * (q + 1) : r * (q + 1) + (xcd - r) * q) + off; }
        const int nig = WGM * nN, gid = wgid / nig, fm = gid * WGM, gsz = (nM - fm) < WGM ? (nM - fm) : WGM;
        u.pm = fm + ((wgid % nig) % gsz); u.pn = (wgid % nig) / gsz; return true;
    }
    __device__ __forceinline__ void a_ready(const Unit&) const {}
    __device__ __forceinline__ void done(const Unit&) const {}
};

__device__ __forceinline__ unsigned cvt_pk_bf16(float lo, float hi) { unsigned r; asm volatile("v_cvt_pk_bf16_f32 %0, %1, %2" : "=v"(r) : "v"(lo), "v"(hi)); return r; }
typedef float f32x2 __attribute__((ext_vector_type(2)));

__device__ __forceinline__ u32x4 pk8(const f32x4& a, const f32x4& b) { u32x4 w; w.x = cvt_pk_bf16(a[0], a[1]); w.y = cvt_pk_bf16(a[2], a[3]); w.z = cvt_pk_bf16(b[0], b[1]); w.w = cvt_pk_bf16(b[2], b[3]); return w; }
__device__ __forceinline__ float fsig(float v) { return __builtin_amdgcn_rcpf(1.f + __builtin_amdgcn_exp2f(-1.4426950408889634f * v)); }
__device__ __forceinline__ f32x4 sig4(const f32x4& v) { return (f32x4){fsig(v[0]), fsig(v[1]), fsig(v[2]), fsig(v[3])}; }
__device__ __forceinline__ f32x4 silu4(const f32x4& v) { return v * sig4(v); }
struct EpiP1 {
    static constexpr bool PERM = true, AFTER_DRAIN = false, HAS_MID = false;
    bf16_t *QA, *CKV, *KR, *ZS, *U, *T, *SG1, *SG2; float* ssq; const float2* rope;
    __device__ __forceinline__ void operator()(const f32x4 (&acc)[2][2][4][2], const Unit& u, int wr, int wc, int fr, int fq) const {
        const int pn = u.pn, row0 = u.pm * BM + wr * 64 + fr, cg = wc * 4 + fq;
        if (pn < 4) {
            bf16_t* dst = (pn < 2 ? QA : CKV) + (pn & 1) * 256 + 8 * cg; const int which = pn >> 1;
#pragma unroll
            for (int ai = 0; ai < 2; ++ai)
#pragma unroll
                for (int m = 0; m < 4; ++m) { const int row = row0 + ai * HALF + m * 16; float ss = 0.f;
#pragma unroll
                    for (int bj = 0; bj < 2; ++bj) { const f32x4 v0 = acc[ai][bj][m][0], v1 = acc[ai][bj][m][1];
                        *(u32x4*)(dst + (size_t)row * 512 + bj * HALF) = pk8(v0, v1);
                        ss += (v0[0] * v0[0] + v0[1] * v0[1]) + (v0[2] * v0[2] + v0[3] * v0[3]) + (v1[0] * v1[0] + v1[1] * v1[1]) + (v1[2] * v1[2] + v1[3] * v1[3]); }
                    ss += __shfl_xor(ss, 16); ss += __shfl_xor(ss, 32);
                    if (fq == 0) atomicAdd(ssq + row * 2 + which, ss); }
        } else if (pn == 4) {
            if (wc == 0) {
#pragma unroll
                for (int ai = 0; ai < 2; ++ai)
#pragma unroll
                    for (int m = 0; m < 4; ++m) { const int row = row0 + ai * HALF + m * 16; const f32x4* cs = (const f32x4*)(rope + (size_t)row * 32 + 8 * fq);
                        f32x4 o1[2], o2[2];
#pragma unroll
                        for (int n = 0; n < 2; ++n) { const f32x4 x1 = acc[ai][0][m][n], x2 = acc[ai][1][m][n]; const f32x4 c01 = cs[2 * n], c23 = cs[2 * n + 1];
                            o1[n] = (f32x4){x1[0] * c01[0] - x2[0] * c01[1], x1[1] * c01[2] - x2[1] * c01[3], x1[2] * c23[0] - x2[2] * c23[1], x1[3] * c23[2] - x2[3] * c23[3]};
                            o2[n] = (f32x4){x1[0] * c01[1] + x2[0] * c01[0], x1[1] * c01[3] + x2[1] * c01[2], x1[2] * c23[1] + x2[2] * c23[0], x1[3] * c23[3] + x2[3] * c23[2]}; }
                        *(u32x4*)(KR + (size_t)row * 64 + 8 * fq) = pk8(o1[0], o1[1]); *(u32x4*)(KR + (size_t)row * 64 + 32 + 8 * fq) = pk8(o2[0], o2[1]); }
            }
        } else if (pn < 13 || pn >= 45) {
            bf16_t* dst = (pn < 13 ? ZS + (pn - 5) * 256 : pn < 53 ? SG1 + (pn - 45) * 256 : SG2 + (pn - 53) * 256) + 8 * cg; const bool sl = pn < 13;
#pragma unroll
            for (int ai = 0; ai < 2; ++ai)
#pragma unroll
                for (int m = 0; m < 4; ++m) { const int row = row0 + ai * HALF + m * 16;
#pragma unroll
                    for (int bj = 0; bj < 2; ++bj) { f32x4 v0 = acc[ai][bj][m][0], v1 = acc[ai][bj][m][1];
                        if (sl) { v0 = silu4(v0); v1 = silu4(v1); } else { v0 = sig4(v0); v1 = sig4(v1); }
                        *(u32x4*)(dst + (size_t)row * 2048 + bj * HALF) = pk8(v0, v1); } }
        } else {
            const int ch0 = 64 * (pn - 13) + 4 * cg;
#pragma unroll
            for (int ai = 0; ai < 2; ++ai)
#pragma unroll
                for (int m = 0; m < 4; ++m) { const int row = row0 + ai * HALF + m * 16;
                    const f32x4 uu = acc[ai][1][m][0] * acc[ai][0][m][0], tt = acc[ai][0][m][1] * silu4(acc[ai][1][m][1]);
                    typedef unsigned u32x2v __attribute__((ext_vector_type(2)));
                    u32x2v wu, wt; wu.x = cvt_pk_bf16(uu[0], uu[1]); wu.y = cvt_pk_bf16(uu[2], uu[3]); wt.x = cvt_pk_bf16(tt[0], tt[1]); wt.y = cvt_pk_bf16(tt[2], tt[3]);
                    *(u32x2v*)(U + (size_t)row * 2048 + ch0) = wu; *(u32x2v*)(T + (size_t)row * 2048 + ch0) = wt; }
        }
    }
};
struct EpiQ {
    static constexpr bool PERM = true, AFTER_DRAIN = false, HAS_MID = false;
    bf16_t *QN, *QR; const float* ssq; const float2* rope;
    __device__ __forceinline__ void operator()(const f32x4 (&acc)[2][2][4][2], const Unit& u, int wr, int wc, int fr, int fq) const {
        const int pn = u.pn, row0 = u.pm * BM + wr * 64 + fr, cg = wc * 4 + fq;
#pragma unroll
        for (int ai = 0; ai < 2; ++ai)
#pragma unroll
            for (int m = 0; m < 4; ++m) { const int row = row0 + ai * HALF + m * 16; const float rs = rsqrtf(ssq[row * 2] * (1.f / 512.f) + 1e-6f) * (0.07216878364870322f * 1.4426950408889634f);
                if (pn < 8) {
#pragma unroll
                    for (int bj = 0; bj < 2; ++bj) *(u32x4*)(QN + (size_t)row * 2048 + pn * 256 + bj * HALF + 8 * cg) = pk8(acc[ai][bj][m][0] * rs, acc[ai][bj][m][1] * rs);
                } else { const int head = 4 * (pn - 8) + wc; const f32x4* cs = (const f32x4*)(rope + (size_t)row * 32 + 8 * fq); f32x4 o1[2], o2[2];
#pragma unroll
                    for (int n = 0; n < 2; ++n) { const f32x4 x1 = acc[ai][0][m][n] * rs, x2 = acc[ai][1][m][n] * rs; const f32x4 c01 = cs[2 * n], c23 = cs[2 * n + 1];
                        o1[n] = (f32x4){x1[0] * c01[0] - x2[0] * c01[1], x1[1] * c01[2] - x2[1] * c01[3], x1[2] * c23[0] - x2[2] * c23[1], x1[3] * c23[2] - x2[3] * c23[3]};
                        o2[n] = (f32x4){x1[0] * c01[1] + x2[0] * c01[0], x1[1] * c01[3] + x2[1] * c01[2], x1[2] * c23[1] + x2[2] * c23[0], x1[3] * c23[3] + x2[3] * c23[2]}; }
                    *(u32x4*)(QR + (size_t)row * 1024 + 64 * head + 8 * fq) = pk8(o1[0], o1[1]); *(u32x4*)(QR + (size_t)row * 1024 + 64 * head + 32 + 8 * fq) = pk8(o2[0], o2[1]); }
            }
    }
};
struct EpiKV {
    static constexpr bool PERM = true, AFTER_DRAIN = false, HAS_MID = false;
    bf16_t *KN, *V; const float* ssq;
    __device__ __forceinline__ void operator()(const f32x4 (&acc)[2][2][4][2], const Unit& u, int wr, int wc, int fr, int fq) const {
        const int pn = u.pn, row0 = u.pm * BM + wr * 64 + fr, cg = wc * 4 + fq; bf16_t* dst = (pn < 8 ? KN + pn * 256 : V + (pn - 8) * 256) + 8 * cg;
#pragma unroll
        for (int ai = 0; ai < 2; ++ai)
#pragma unroll
            for (int m = 0; m < 4; ++m) { const int row = row0 + ai * HALF + m * 16; const float rs = rsqrtf(ssq[row * 2 + 1] * (1.f / 512.f) + 1e-6f);
#pragma unroll
                for (int bj = 0; bj < 2; ++bj) *(u32x4*)(dst + (size_t)row * 2048 + bj * HALF) = pk8(acc[ai][bj][m][0] * rs, acc[ai][bj][m][1] * rs); }
    }
};
__device__ __forceinline__ void unpk8(const u32x4& w, f32x4& a, f32x4& b) {
    a = (f32x4){__uint_as_float(w.x << 16), __uint_as_float(w.x & 0xffff0000u), __uint_as_float(w.y << 16), __uint_as_float(w.y & 0xffff0000u)};
    b = (f32x4){__uint_as_float(w.z << 16), __uint_as_float(w.z & 0xffff0000u), __uint_as_float(w.w << 16), __uint_as_float(w.w & 0xffff0000u)}; }
struct EpiMerge {
    static constexpr bool PERM = true, AFTER_DRAIN = false, HAS_MID = true;
    const bf16_t *sg1, *sg2; bf16_t* mg;
    __device__ __forceinline__ void mid(f32x4 (&acc)[2][2][4][2], const Unit& u, int wr, int wc, int fr, int fq) const {
        const size_t ub = (size_t)(u.pm * BM + wr * 64) * 2048 + u.pn * BM + 32 * wc; const unsigned lo = (unsigned)(fr * 2048 + 8 * fq);
#pragma unroll
        for (int ai = 0; ai < 2; ++ai)
#pragma unroll
            for (int m = 0; m < 4; ++m) { unsigned lo_ = lo; asm volatile("" : "+v"(lo_)); const size_t ro = ub + (size_t)(ai * HALF + m * 16) * 2048 + lo_;
#pragma unroll
                for (int bj = 0; bj < 2; ++bj) { f32x4 g0, g1, h0, h1; { const u32x4 q_ = *(const u32x4*)(sg1 + ro + bj * HALF); unpk8(q_, g0, g1); } { const u32x4 q_ = *(const u32x4*)(sg2 + ro + bj * HALF); unpk8(q_, h0, h1); }
#pragma unroll
                    for (int j = 0; j < 4; ++j) { acc[ai][bj][m][0][j] *= g0[j] * __builtin_amdgcn_rcpf(h0[j]); acc[ai][bj][m][1][j] *= g1[j] * __builtin_amdgcn_rcpf(h1[j]); } }
                asm volatile("" ::: "memory"); }
    }
    __device__ __forceinline__ void operator()(const f32x4 (&acc)[2][2][4][2], const Unit& u, int wr, int wc, int fr, int fq) const {
        const size_t ub = (size_t)(u.pm * BM + wr * 64) * 2048 + u.pn * BM + 32 * wc; const unsigned lo = (unsigned)(fr * 2048 + 8 * fq);
#pragma unroll
        for (int ai = 0; ai < 2; ++ai)
#pragma unroll
            for (int m = 0; m < 4; ++m) { unsigned lo_ = lo; asm volatile("" : "+v"(lo_)); const size_t ro = ub + (size_t)(ai * HALF + m * 16) * 2048 + lo_;
#pragma unroll
                for (int bj = 0; bj < 2; ++bj) { f32x4 h0, h1; { const u32x4 q_ = *(const u32x4*)(sg2 + ro + bj * HALF); unpk8(q_, h0, h1); }
                    *(u32x4*)(mg + ro + bj * HALF) = pk8(acc[ai][bj][m][0] * h0, acc[ai][bj][m][1] * h1); }
                asm volatile("" ::: "memory"); }
    }
};
struct EpiOut {
    static constexpr bool PERM = true, AFTER_DRAIN = false, HAS_MID = false;
    float* outf;
    __device__ __forceinline__ void operator()(const f32x4 (&acc)[2][2][4][2], const Unit& u, int wr, int wc, int fr, int fq) const {
        const int row0 = u.pm * BM + wr * 64 + fr, col0 = u.pn * BM + 8 * (wc * 4 + fq);
#pragma unroll
        for (int ai = 0; ai < 2; ++ai)
#pragma unroll
            for (int m = 0; m < 4; ++m) { const size_t ro = (size_t)(row0 + ai * HALF + m * 16) * 2048 + col0;
#pragma unroll
                for (int bj = 0; bj < 2; ++bj) { *(f32x4*)(outf + ro + bj * HALF) = acc[ai][bj][m][0]; *(f32x4*)(outf + ro + bj * HALF + 4) = acc[ai][bj][m][1]; } }
    }
};

template <class Epi, class Sched, bool ALIGN_EPI = false, bool SP2 = false>
__device__ __forceinline__ void gemm_phase(PG8_LAS unsigned char* lds, const Gemm g, const Sched& S, const Epi& E) {
    const int tid = threadIdx.x, wid = __builtin_amdgcn_readfirstlane(tid >> 6), lane = tid & 63, wr = wid >> 2, wc = wid & 3, fr = lane & 15, fq = lane >> 4;
    const int K = g.K, ns = K / BK, nt = g.A2 ? 2 * ns : ns;
    unsigned voffA[2], voffB[2];
#pragma unroll
    for (int i = 0; i < 2; ++i) { int R, C; stage_rc(tid * 16 + i * 8192, R, C); const int Rb = Epi::PERM ? ((R & ~31) + perm32(R & 31)) : R;
        voffA[i] = (unsigned)(R * K + C) * 2u; voffB[i] = (unsigned)(Rb * K + C) * 2u; }
    const size_t kstep = (size_t)(BK * 2);
    const size_t hstep = (size_t)HALF * K * 2;
    const size_t tstep = 2 * hstep;
    const unsigned ldsw = (unsigned)wid * 1024u;
    const int aoff = lds_byte(wr * 64 + fr, fq * 8), boff = lds_byte(wc * 32 + fr, fq * 8);
#define PG8_SA(b, h) (((b) * 2 + (h)) * HTB)
#define PG8_SB(b, h) ((4 + (b) * 2 + (h)) * HTB)
#define PG8_STAGE(bufoff, gbase, voff) do { _Pragma("unroll") for (int _i = 0; _i < 2; ++_i) \
        __builtin_amdgcn_global_load_lds((const unsigned*)((const char*)(gbase) + (voff)[_i]), (PG8_LAS unsigned*)(lds + (bufoff) + ldsw + _i * 8192), 16, 0, 0); } while (0)
#define PG8_LDA(dst, b, h) do { _Pragma("unroll") for (int m = 0; m < 4; ++m) _Pragma("unroll") for (int k = 0; k < 2; ++k) dst[m][k] = *(const PG8_LAS bf16x8*)(lds + PG8_SA(b, h) + aoff + m * 2048 + k * 1024); } while (0)
#define PG8_LDB(dst, b, h) do { _Pragma("unroll") for (int n = 0; n < 2; ++n) _Pragma("unroll") for (int k = 0; k < 2; ++k) dst[n][k] = *(const PG8_LAS bf16x8*)(lds + PG8_SB(b, h) + boff + n * 2048 + k * 1024); } while (0)
#define PG8_MMA(ai, bj, At, Bt) do { __builtin_amdgcn_s_setprio(1); _Pragma("unroll") for (int m = 0; m < 4; ++m) _Pragma("unroll") for (int n = 0; n < 2; ++n) _Pragma("unroll") for (int k = 0; k < 2; ++k) \
        acc[ai][bj][m][n] = __builtin_amdgcn_mfma_f32_16x16x32_bf16(Bt[n][k], At[m][k], acc[ai][bj][m][n], 0, 0, 0); __builtin_amdgcn_s_setprio(0); } while (0)
#define PG8_WAIT_V(n) asm volatile("s_waitcnt vmcnt(" #n ")" ::: "memory")
#define PG8_WAIT_L(n) asm volatile("s_waitcnt lgkmcnt(" #n ")" ::: "memory")
#define PG8_BAR __builtin_amdgcn_s_barrier()
#define PG8_SCHED __builtin_amdgcn_sched_barrier(0)
    Unit cur, nxt; int ui = 0;
    if (!S.next(0, cur)) return;
    f32x4 acc[2][2][4][2];
#pragma unroll
    for (int a = 0; a < 2; ++a)
#pragma unroll
        for (int b = 0; b < 2; ++b)
#pragma unroll
            for (int m = 0; m < 4; ++m)
#pragma unroll
                for (int n = 0; n < 2; ++n) acc[a][b][m][n] = (f32x4){0.f, 0.f, 0.f, 0.f};
    bf16x8 At[4][2], B0[2][2], B1[2][2];
    const char* cA = (const char*)g.A + (size_t)cur.pm * tstep; const char* cB = (const char*)g.Bt + (size_t)cur.pn * tstep;
    const long dA = g.A2 ? ((const char*)g.A2 - (const char*)g.A) - (long)ns * (long)kstep : 0, dB = g.A2 ? ((const char*)g.Bt2 - (const char*)g.Bt) - (long)ns * (long)kstep : 0;
    S.a_ready(cur);
    if constexpr (SP2) {
        PG8_STAGE(PG8_SB(0, 0), cB, voffB); PG8_STAGE(PG8_SB(0, 1), cB + hstep, voffB); PG8_STAGE(PG8_SA(0, 0), cA, voffA); PG8_STAGE(PG8_SA(0, 1), cA + hstep, voffA);
        if (wr == 1) PG8_BAR;
        PG8_WAIT_V(2); PG8_BAR;
        PG8_STAGE(PG8_SB(1, 0), cB + kstep, voffB); PG8_STAGE(PG8_SA(1, 0), cA + kstep, voffA); PG8_STAGE(PG8_SB(1, 1), cB + hstep + kstep, voffB);
        PG8_WAIT_V(6); PG8_BAR;
    } else {
        PG8_STAGE(PG8_SB(0, 0), cB, voffB); PG8_STAGE(PG8_SA(0, 0), cA, voffA); PG8_STAGE(PG8_SB(0, 1), cB + hstep, voffB); PG8_STAGE(PG8_SA(0, 1), cA + hstep, voffA);
        if (wr == 1) PG8_BAR;
        PG8_WAIT_V(4); PG8_BAR;
        PG8_STAGE(PG8_SB(1, 0), cB + kstep, voffB); PG8_STAGE(PG8_SA(1, 0), cA + kstep, voffA); PG8_STAGE(PG8_SB(1, 1), cB + hstep + kstep, voffB);
        PG8_WAIT_V(6); PG8_BAR;
    }
    for (;;) {
        const bool has_next = S.next(ui + 1, nxt);
        const char* nA = has_next ? (const char*)g.A + (size_t)nxt.pm * tstep : cA; const char* nB = has_next ? (const char*)g.Bt + (size_t)nxt.pn * tstep : cB;
        for (int t0 = 0; t0 < nt; t0 += ns) {
        if constexpr (Epi::HAS_MID) { if (t0 != 0) { PG8_SCHED; E.mid(acc, cur, wr, wc, fr, fq); PG8_SCHED; } }
        for (int t = t0; t < t0 + ns; t += 2) {
            const bool last = (t == nt - 2);
            const int t1 = t + 1, t2 = t + 2;
            const char* a1 = cA + (size_t)t1 * kstep + (t1 >= ns ? dA : 0);
            const char* a2 = last ? nA : cA + (size_t)t2 * kstep + (t2 >= ns ? dA : 0);
            const char* b2 = last ? nB : cB + (size_t)t2 * kstep + (t2 >= ns ? dB : 0);
            const char* a3 = a2 + kstep; const char* b3 = b2 + kstep;
            if (last && has_next) S.a_ready(nxt);
            if constexpr (SP2) {
            PG8_LDB(B0, 0, 0); PG8_LDB(B1, 0, 1); PG8_SCHED; PG8_LDA(At, 0, 0); PG8_STAGE(PG8_SA(1, 1), a1 + hstep, voffA);
            PG8_WAIT_V(8); PG8_WAIT_L(0); PG8_BAR; PG8_MMA(0, 0, At, B0); PG8_MMA(0, 1, At, B1); PG8_BAR; PG8_SCHED;
            PG8_LDA(At, 0, 1); PG8_STAGE(PG8_SB(0, 0), b2, voffB); PG8_STAGE(PG8_SB(0, 1), b2 + hstep, voffB); PG8_STAGE(PG8_SA(0, 0), a2, voffA);
            PG8_WAIT_V(8); PG8_WAIT_L(0); PG8_BAR; PG8_MMA(1, 0, At, B0); PG8_MMA(1, 1, At, B1); PG8_BAR; PG8_SCHED;
            PG8_LDB(B0, 1, 0); PG8_LDB(B1, 1, 1); PG8_SCHED; PG8_LDA(At, 1, 0); PG8_STAGE(PG8_SA(0, 1), a2 + hstep, voffA);
            PG8_WAIT_V(8); PG8_WAIT_L(0); PG8_BAR; PG8_MMA(0, 0, At, B0); PG8_MMA(0, 1, At, B1); PG8_BAR; PG8_SCHED;
            PG8_LDA(At, 1, 1); PG8_STAGE(PG8_SB(1, 0), b3, voffB); PG8_STAGE(PG8_SB(1, 1), b3 + hstep, voffB); PG8_STAGE(PG8_SA(1, 0), a3, voffA);
            PG8_WAIT_V(8); PG8_WAIT_L(0); PG8_BAR; PG8_MMA(1, 0, At, B0); PG8_MMA(1, 1, At, B1); PG8_BAR; PG8_SCHED;
            } else {
            PG8_LDB(B0, 0, 0); PG8_SCHED; PG8_LDA(At, 0, 0); PG8_STAGE(PG8_SA(1, 1), a1 + hstep, voffA);
            PG8_WAIT_L(8); PG8_BAR; PG8_WAIT_L(0); PG8_MMA(0, 0, At, B0); PG8_BAR; PG8_SCHED;
            PG8_LDB(B1, 0, 1); PG8_STAGE(PG8_SB(0, 0), b2, voffB);
            PG8_BAR; PG8_WAIT_L(0); PG8_MMA(0, 1, At, B1); PG8_BAR;
            PG8_LDA(At, 0, 1); PG8_STAGE(PG8_SA(0, 0), a2, voffA);
            PG8_BAR; PG8_WAIT_L(0); PG8_MMA(1, 0, At, B0); PG8_BAR; PG8_SCHED;
            PG8_STAGE(PG8_SB(0, 1), b2 + hstep, voffB);
            PG8_WAIT_V(6); PG8_BAR; PG8_MMA(1, 1, At, B1); PG8_BAR;
            PG8_LDB(B0, 1, 0); PG8_SCHED; PG8_LDA(At, 1, 0); PG8_STAGE(PG8_SA(0, 1), a2 + hstep, voffA);
            PG8_WAIT_L(8); PG8_BAR; PG8_WAIT_L(0); PG8_MMA(0, 0, At, B0); PG8_BAR; PG8_SCHED;
            PG8_LDB(B1, 1, 1); PG8_STAGE(PG8_SB(1, 0), b3, voffB);
            PG8_BAR; PG8_WAIT_L(0); PG8_MMA(0, 1, At, B1); PG8_BAR;
            PG8_LDA(At, 1, 1); PG8_STAGE(PG8_SA(1, 0), a3, voffA);
            PG8_BAR; PG8_WAIT_L(0); PG8_MMA(1, 0, At, B0); PG8_BAR; PG8_SCHED;
            PG8_STAGE(PG8_SB(1, 1), b3 + hstep, voffB);
            PG8_WAIT_V(6); PG8_BAR; PG8_MMA(1, 1, At, B1); PG8_BAR;
            }
        }
        }
        if constexpr (ALIGN_EPI) { if (wr == 0) PG8_BAR; }
        if constexpr (!Epi::AFTER_DRAIN) { E(acc, cur, wr, wc, fr, fq); S.done(cur); }
        if (!has_next) break;
#pragma unroll
        for (int a = 0; a < 2; ++a)
#pragma unroll
            for (int b = 0; b < 2; ++b)
#pragma unroll
                for (int m = 0; m < 4; ++m)
#pragma unroll
                    for (int n = 0; n < 2; ++n) acc[a][b][m][n] = (f32x4){0.f, 0.f, 0.f, 0.f};
        cur = nxt; cA = nA; cB = nB; ++ui;
        if constexpr (ALIGN_EPI) { if (wr == 1) PG8_BAR; }
    }
    PG8_WAIT_V(0);
    if constexpr (!ALIGN_EPI) { if (wr == 0) PG8_BAR; }
    PG8_BAR;
    if constexpr (Epi::AFTER_DRAIN) { E.fused(acc, cur, wr, wc, fr, fq, lds, wid, lane); S.done(cur); }
#undef PG8_SA
#undef PG8_SB
#undef PG8_STAGE
#undef PG8_LDA
#undef PG8_LDB
#undef PG8_MMA
#undef PG8_WAIT_V
#undef PG8_WAIT_L
#undef PG8_BAR
#undef PG8_SCHED
}
}

namespace att {
typedef short bf16x8 __attribute__((ext_vector_type(8)));
typedef short s16x4 __attribute__((ext_vector_type(4)));
typedef float f32x16 __attribute__((ext_vector_type(16)));
typedef float f32x4 __attribute__((ext_vector_type(4)));
typedef unsigned u32x4 __attribute__((ext_vector_type(4)));
constexpr int NW = 8, QBLK = 32, KVBLK = 64, QB = NW * QBLK, NQB = S / QB;
constexpr int SHM_V = KVBLK * 128 * 2, SHM_KN = KVBLK * 128 * 2, SHM_KR = KVBLK * 64 * 2;
constexpr int OFF_V = 0, OFF_KN = 2 * SHM_V, OFF_KR = OFF_KN + 2 * SHM_KN, OFF_WS = OFF_KR + 2 * SHM_KR, OFF_QR = OFF_WS + NW * 64 * 4, LDS_BYTES = OFF_QR + NW * 4096;
constexpr float THR2 = 8.f * 1.4426950408889634f;
#define KSWZ(row, colB) ((row) * 256 + ((colB) ^ (((row) & 7) << 4)))
#define SBAR() __builtin_amdgcn_sched_barrier(0)
__device__ __forceinline__ int kr_off(int row, int ch8) { return (ch8 >> 2) * 4096 + row * 64 + (((ch8 & 3) ^ ((row >> 2) & 3)) << 4); }
__device__ __forceinline__ int v_st(int k, int c) { const int kk = (k & ~0xC) | ((k & 4) << 1) | ((k & 8) >> 1); return ((kk >> 3) * 4 + (c >> 5)) * 512 + ((kk & 7) * 32 + (c & 31)) * 2; }
__device__ __forceinline__ int v_rd_base(int lane) { return ((lane & 3) << 3) | (((lane >> 2) & 3) << 6) | (((lane >> 4) & 1) << 5) | (((lane >> 5) & 1) << 8); }
constexpr int v_rd_off(int d0, int ks, int half) { return d0 * 512 + ks * 4096 + half * 2048; }
__device__ __forceinline__ int crow(int r, int hi) { return (r & 3) + 8 * (r >> 2) + 4 * hi; }
__device__ __forceinline__ unsigned cvtpk(float lo, float hi) { unsigned r; asm volatile("v_cvt_pk_bf16_f32 %0, %1, %2" : "=v"(r) : "v"(lo), "v"(hi)); return r; }
__device__ __forceinline__ void mask_tile(f32x16& p0, f32x16& p1, int dq) {
    const float NEG = -__builtin_inff();
#pragma unroll
    for (int r = 0; r < 16; ++r) { const int c = (r & 3) + 8 * (r >> 2);
        if (dq - c < 0) p0[r] = NEG;
        if (dq - c - 32 < 0) p1[r] = NEG; }
}
__device__ __forceinline__ void partialSM(f32x16& p0, f32x16& p1, float& m_reg, float& mn, float& alpha) {
    float pmax = p0[0];
#pragma unroll
    for (int r = 1; r < 16; ++r) pmax = fmaxf(pmax, p0[r]);
#pragma unroll
    for (int r = 0; r < 16; ++r) pmax = fmaxf(pmax, p1[r]);
    { auto rr = __builtin_amdgcn_permlane32_swap(__float_as_uint(pmax), __float_as_uint(pmax), false, false);
      pmax = fmaxf(__uint_as_float(rr[0]), __uint_as_float(rr[1])); }
    if (__builtin_expect(__all((pmax - m_reg) <= THR2), 1)) { mn = m_reg; alpha = 1.f; }
    else { mn = fmaxf(m_reg, pmax); alpha = __builtin_amdgcn_exp2f(m_reg - mn); m_reg = mn; }
#pragma unroll
    for (int r = 0; r < 16; ++r) p0[r] = p0[r] - mn;
#pragma unroll
    for (int r = 0; r < 16; ++r) p1[r] = p1[r] - mn;
#pragma unroll
    for (int r = 0; r < 16; ++r) p0[r] = __builtin_amdgcn_exp2f(p0[r]);
}
__device__ __forceinline__ void finishSM(f32x16& p0, f32x16& p1, float alpha, float& l_reg, bf16x8& pa0, bf16x8& pa1, bf16x8& pa2, bf16x8& pa3) {
#pragma unroll
    for (int r = 0; r < 16; ++r) p1[r] = __builtin_amdgcn_exp2f(p1[r]);
    float ps = 0;
#pragma unroll
    for (int r = 0; r < 16; ++r) ps += p0[r];
#pragma unroll
    for (int r = 0; r < 16; ++r) ps += p1[r];
    { auto rr = __builtin_amdgcn_permlane32_swap(__float_as_uint(ps), __float_as_uint(ps), false, false);
      ps = __uint_as_float(rr[0]) + __uint_as_float(rr[1]); }
    l_reg = l_reg * alpha + ps;
#define PK4(P, B_, OUT) do { unsigned a0 = cvtpk(P[B_+0], P[B_+1]), a1 = cvtpk(P[B_+2], P[B_+3]);                          \
        unsigned b0 = cvtpk(P[B_+4], P[B_+5]), b1 = cvtpk(P[B_+6], P[B_+7]);                                             \
        auto r0 = __builtin_amdgcn_permlane32_swap(a0, b0, false, false); auto r1 = __builtin_amdgcn_permlane32_swap(a1, b1, false, false); \
        u32x4 w = {r0[0], r1[0], r0[1], r1[1]}; OUT = *reinterpret_cast<bf16x8*>(&w); } while (0)
    PK4(p0, 0, pa0); PK4(p0, 8, pa1); PK4(p1, 0, pa2); PK4(p1, 8, pa3);
#undef PK4
}
template <int KB>
__device__ __forceinline__ void qkt(f32x16& p0, f32x16& p1, const char* lds, int r32, int hi, const bf16x8* qr, const char* ql0, const char* ql1) {
    p0 = f32x16{}; p1 = f32x16{};
    const char* kb[4];
#pragma unroll
    for (int dd = 0; dd < 4; ++dd) kb[dd] = lds + OFF_KN + KB * SHM_KN + KSWZ(r32, (dd * 16 + hi * 8) * 2);
#pragma unroll
    for (int d0 = 0; d0 < 8; ++d0) { const char* a = kb[d0 & 3] + (d0 >> 2) * 128;
        bf16x8 b0 = *reinterpret_cast<const bf16x8*>(a);
        bf16x8 b1 = *reinterpret_cast<const bf16x8*>(a + 32 * 256);
        p0 = __builtin_amdgcn_mfma_f32_32x32x16_bf16(b0, qr[d0], p0, 0, 0, 0);
        p1 = __builtin_amdgcn_mfma_f32_32x32x16_bf16(b1, qr[d0], p1, 0, 0, 0); }
    const char* kr[2];
#pragma unroll
    for (int e = 0; e < 2; ++e) kr[e] = lds + OFF_KR + KB * SHM_KR + kr_off(r32, 2 * e + hi);
#pragma unroll
    for (int d0 = 0; d0 < 4; ++d0) { const char* a = kr[d0 & 1] + (d0 >> 1) * 4096;
        bf16x8 b0 = *reinterpret_cast<const bf16x8*>(a);
        bf16x8 b1 = *reinterpret_cast<const bf16x8*>(a + 32 * 64);
        const bf16x8 qf = *reinterpret_cast<const bf16x8*>(((d0 & 1) ? ql1 : ql0) + (d0 >> 1) * 2048);
        p0 = __builtin_amdgcn_mfma_f32_32x32x16_bf16(b0, qf, p0, 0, 0, 0);
        p1 = __builtin_amdgcn_mfma_f32_32x32x16_bf16(b1, qf, p1, 0, 0, 0); }
}
template <int VB>
__device__ __forceinline__ void pv_tile(f32x16* o, int vb0, bf16x8 pa0, bf16x8 pa1, bf16x8 pa2, bf16x8 pa3) {
#define TRRD(dst, off) asm volatile("ds_read_b64_tr_b16 %0, %1 offset:%2" : "=&v"(dst) : "v"(vb0), "i"(off) : "memory")
#define PV_D0(d0) do { s16x4 l0, l1, l2, l3, h0, h1, h2, h3; constexpr int b_ = OFF_V + VB * SHM_V + v_rd_off(d0, 0, 0);     \
        TRRD(l0, b_); TRRD(h0, b_ + 2048); TRRD(l1, b_ + 4096); TRRD(h1, b_ + 6144); TRRD(l2, b_ + 8192); TRRD(h2, b_ + 10240); TRRD(l3, b_ + 12288); TRRD(h3, b_ + 14336); \
        asm volatile("s_waitcnt lgkmcnt(0)" ::: "memory"); SBAR();   \
        o[d0] = __builtin_amdgcn_mfma_f32_32x32x16_bf16(pa0, (bf16x8){l0[0], l0[1], l0[2], l0[3], h0[0], h0[1], h0[2], h0[3]}, o[d0], 0, 0, 0);   \
        o[d0] = __builtin_amdgcn_mfma_f32_32x32x16_bf16(pa1, (bf16x8){l1[0], l1[1], l1[2], l1[3], h1[0], h1[1], h1[2], h1[3]}, o[d0], 0, 0, 0);   \
        o[d0] = __builtin_amdgcn_mfma_f32_32x32x16_bf16(pa2, (bf16x8){l2[0], l2[1], l2[2], l2[3], h2[0], h2[1], h2[2], h2[3]}, o[d0], 0, 0, 0);   \
        o[d0] = __builtin_amdgcn_mfma_f32_32x32x16_bf16(pa3, (bf16x8){l3[0], l3[1], l3[2], l3[3], h3[0], h3[1], h3[2], h3[3]}, o[d0], 0, 0, 0); } while (0)
    PV_D0(0); PV_D0(1); PV_D0(2); PV_D0(3);
#undef PV_D0
#undef TRRD
}
struct Tens { const bf16_t *QN, *QR, *KN, *KR, *V, *ZS; bf16_t* AO; };
struct BlockRef { int h, P0; };
struct Stage { bf16x8 st_v0, st_v1, st_k0, st_k1, st_kr; };
#define VMW() asm volatile("s_waitcnt vmcnt(0)" ::: "memory")
#define LD8(p) (*reinterpret_cast<const bf16x8*>(p))
#define SLOAD_H(hh, k0) do { const bf16_t* vp_ = T.V + (size_t)((k0) + sr) * 2048 + (hh) * 128 + sc; const bf16_t* kp_ = T.KN + (size_t)((k0) + sr) * 2048 + (hh) * 128 + sc;   \
        G.st_v0 = LD8(vp_); G.st_v1 = LD8(vp_ + 32 * 2048); G.st_k0 = LD8(kp_); G.st_k1 = LD8(kp_ + 32 * 2048); G.st_kr = LD8(T.KR + (size_t)((k0) + krow) * 64 + kch * 8); } while (0)
#define SWRITE_H(bf) do { *(bf16x8*)(lds + OFF_V + (bf) * SHM_V + vst0) = G.st_v0; *(bf16x8*)(lds + OFF_V + (bf) * SHM_V + vst1) = G.st_v1;                          \
        *(bf16x8*)(lds + OFF_KN + (bf) * SHM_KN + kws) = G.st_k0; *(bf16x8*)(lds + OFF_KN + (bf) * SHM_KN + kws + 32 * 256) = G.st_k1; *(bf16x8*)(lds + OFF_KR + (bf) * SHM_KR + krws) = G.st_kr; } while (0)
__device__ __forceinline__ void softmax_tile(f32x16& p0, f32x16& p1, float& m_reg, float& l_reg, float& alpha, bf16x8& pa0, bf16x8& pa1, bf16x8& pa2, bf16x8& pa3) {
    float mn; partialSM(p0, p1, m_reg, mn, alpha);
    finishSM(p0, p1, alpha, l_reg, pa0, pa1, pa2, pa3);
}
__device__ __forceinline__ void attn_block(const Tens& T, const BlockRef& cur, char* lds) {
    const int tid = threadIdx.x, wid = __builtin_amdgcn_readfirstlane(tid >> 6), lane = tid & 63, r32 = lane & 31, hi = lane >> 5;
    const int NT = (cur.P0 + QB) / KVBLK;
    const int qlo = cur.P0 + wid * QBLK, qm = qlo + r32 - 4 * hi;
    float* ws = (float*)(lds + OFF_WS) + wid * 64; float* li_l = ws, * al_l = ws + 32;
    float m_reg = -1e30f, l_reg = 0; f32x16 o[4] = {};
    const int sr = tid >> 4, sc = (tid & 15) * 8, vst0 = v_st(sr, sc), vst1 = v_st(32 + sr, sc), kws = KSWZ(sr, sc * 2), krow = tid >> 3, kch = tid & 7, krws = kr_off(krow, kch);
    const int vb0 = (int)(uintptr_t)(lds) + v_rd_base(lane);
    const int hh = cur.h;
    Stage G; bf16x8 qr[8];
    char* const ql0 = lds + OFF_QR + wid * 4096 + r32 * 64 + (((hi) ^ ((r32 >> 2) & 3)) << 4); char* const ql1 = lds + OFF_QR + wid * 4096 + r32 * 64 + (((2 + hi) ^ ((r32 >> 2) & 3)) << 4);
    SLOAD_H(hh, 0);
    { const size_t qrow_ = (size_t)(cur.P0 + wid * QBLK + r32);
#pragma unroll
      for (int d0 = 0; d0 < 8; ++d0) qr[d0] = LD8(T.QN + qrow_ * 2048 + hh * 128 + d0 * 16 + hi * 8);
      const bf16_t* qp_ = T.QR + qrow_ * 1024 + hh * 64 + hi * 8;
      const bf16x8 t0 = LD8(qp_), t1 = LD8(qp_ + 16), t2 = LD8(qp_ + 32), t3 = LD8(qp_ + 48);
      *(bf16x8*)(ql0) = t0; *(bf16x8*)(ql1) = t1; *(bf16x8*)(ql0 + 2048) = t2; *(bf16x8*)(ql1 + 2048) = t3; }
    VMW(); SWRITE_H(0);
    SLOAD_H(hh, KVBLK);
    f32x16 p0, p1; float alpha; bf16x8 pa0, pa1, pa2, pa3;
#define TILE(t, BF) do {                                                                                                      \
        __syncthreads();                                        \
        if ((t) + 1 < NT) { VMW(); SWRITE_H((BF) ^ 1); }                                                                     \
        if ((t) + 2 < NT) { SLOAD_H(hh, ((t) + 2) * KVBLK); }                                                                \
        SBAR(); qkt<BF>(p0, p1, lds, r32, hi, qr, ql0, ql1);                                                                  \
        { const int kb_ = (t) * KVBLK; if (kb_ + KVBLK - 1 > qlo) mask_tile(p0, p1, qm - kb_); }                              \
        softmax_tile(p0, p1, m_reg, l_reg, alpha, pa0, pa1, pa2, pa3);                                                        \
        if (__any(alpha < 1.f)) { if (hi == 0) al_l[r32] = alpha; asm volatile("s_waitcnt lgkmcnt(0)" ::: "memory");          \
            _Pragma("unroll") for (int d_ = 0; d_ < 4; ++d_) _Pragma("unroll") for (int r = 0; r < 16; ++r) o[d_][r] *= al_l[crow(r, hi)]; }   \
        SBAR(); pv_tile<BF>(o, vb0, pa0, pa1, pa2, pa3); } while (0)
    for (int t = 0; t < NT; t += 2) { TILE(t, 0); TILE(t + 1, 1); }
#undef TILE
    if (hi == 0) li_l[r32] = l_reg; asm volatile("s_waitcnt lgkmcnt(0)" ::: "memory");
    float rli[16];
#pragma unroll
    for (int r = 0; r < 16; ++r) rli[r] = __builtin_amdgcn_rcpf(li_l[crow(r, hi)]);
    const size_t ob = (size_t)(cur.P0 + wid * QBLK) * 2048 + hh * 128;
#pragma unroll
    for (int r = 0; r < 16; ++r) { const int orow = crow(r, hi);
#pragma unroll
        for (int d0 = 0; d0 < 4; ++d0) { const size_t idx = ob + (size_t)orow * 2048 + d0 * 32 + r32;
            const float v = o[d0][r] * rli[r] * bf2f(T.ZS[idx]);
            const float vn = __shfl_xor(v, 1);
            if ((r32 & 1) == 0) *(unsigned*)(T.AO + idx) = cvtpk(v, vn); } }
    __syncthreads();
}
__device__ __forceinline__ BlockRef item_ref(int L, int pass) { const int xc = L & 7, k = L >> 3; BlockRef r; r.h = 2 * xc + (k >> 4); const int x = k & 15; r.P0 = (pass ? 31 - x : x) * QB; return r; }
__device__ __forceinline__ void attn_phase(const Tens& T, char* lds) {
    for (int L = blockIdx.x; L < NH * 16; L += gridDim.x)
        for (int pass = 0; pass < 2; ++pass) attn_block(T, item_ref(L, pass), lds);
}
#undef VMW
#undef LD8
#undef SLOAD_H
#undef SWRITE_H
#undef KSWZ
#undef SBAR
}

#define XB_TMO      128
#define XB_XCNT(j)  (256  + 64 * (j))
#define XB_XSUB(j)  (1280 + 64 * (j))
#define XB_XGEN(j)  (2304 + 64 * (j))
#define XB_TOP      3328
#define XB_TOPGEN   3392
#define XCD_BAR_WORDS 3456
#define XB_SPIN_CAP (1u << 18)

__device__ __forceinline__ unsigned xb_ld(unsigned* p)              { return __hip_atomic_load(p, __ATOMIC_RELAXED, __HIP_MEMORY_SCOPE_AGENT); }
__device__ __forceinline__ unsigned xb_add(unsigned* p, unsigned v) { return __hip_atomic_fetch_add(p, v, __ATOMIC_RELAXED, __HIP_MEMORY_SCOPE_AGENT); }
__device__ __forceinline__ unsigned xb_xcc_id() { return (unsigned)__builtin_amdgcn_s_getreg((3 << 11) | 20) & 0xFu; }
#define XB_SPIN(cond, bar) do { unsigned _sp = 0; while (cond) { __builtin_amdgcn_s_sleep(1); \
    if ((++_sp & 255u) == 0u) { if (xb_ld(&(bar)[XB_TMO])) break; if (_sp > XB_SPIN_CAP) { atomicAdd(&(bar)[XB_TMO], 1u); break; } } } } while (0)

struct XcdBarrier {
    unsigned* bar; unsigned x;
    volatile LAS unsigned* st;
};

__device__ __forceinline__ XcdBarrier xcd_barrier_post(unsigned* bar, volatile LAS unsigned* st) {
    XcdBarrier b; b.bar = bar; b.x = xb_xcc_id(); b.st = st;
    if (threadIdx.x == 0) (void)xb_add(&bar[XB_XCNT(b.x)], 1u);
    return b;
}
__device__ __forceinline__ void xcd_barrier_complete(unsigned* bar, unsigned x, unsigned& nloc, unsigned& nx) {
    const unsigned G = gridDim.x * gridDim.y * gridDim.z;
    unsigned sum, cnt, mine, sp = 0u;
    for (;;) {
        sum = 0u; cnt = 0u; mine = 0u;
#pragma unroll
        for (unsigned j = 0; j < 16; ++j) { const unsigned c = xb_ld(&bar[XB_XCNT(j)]); sum += c; cnt += (c > 0u) ? 1u : 0u; mine = (j == x) ? c : mine; }
        if (sum == G) break;
        __builtin_amdgcn_s_sleep(1);
        if ((++sp & 255u) == 0u) { if (xb_ld(&bar[XB_TMO])) break; if (sp > XB_SPIN_CAP) { atomicAdd(&bar[XB_TMO], 1u); break; } }
    }
    nloc = mine > 0u ? mine : 1u; nx = cnt > 0u ? cnt : 1u;
}

__device__ __forceinline__ void xcd_barrier(const XcdBarrier& b) {
    asm volatile("s_waitcnt vmcnt(0)" ::: "memory");
    __syncthreads();
    if (threadIdx.x == 0) {
        unsigned* bar = b.bar;
        __builtin_amdgcn_s_waitcnt(0);
        unsigned nloc = b.st[0], nx = b.st[1];
        if (nloc == 0u) { xcd_barrier_complete(bar, b.x, nloc, nx); b.st[0] = nloc; b.st[1] = nx; }
        const unsigned old = xb_add(&bar[XB_XSUB(b.x)], 1u);
        const unsigned gen = old / nloc;
        if (old + 1u == (gen + 1u) * nloc) {
            __builtin_amdgcn_fence(__ATOMIC_RELEASE, "agent");
            asm volatile("s_waitcnt vmcnt(0)" ::: "memory");
            const unsigned og = xb_add(&bar[XB_TOP], 1u);
            const unsigned tg = og / nx;
            if (og + 1u == (tg + 1u) * nx) xb_add(&bar[XB_TOPGEN], 1u);
            else XB_SPIN(xb_ld(&bar[XB_TOPGEN]) == tg, bar);
            __builtin_amdgcn_fence(__ATOMIC_ACQUIRE, "agent");
            xb_add(&bar[XB_XGEN(b.x)], 1u);
            asm volatile("s_waitcnt vmcnt(0)" ::: "memory");
        } else {
            XB_SPIN(xb_ld(&bar[XB_XGEN(b.x)]) == gen, bar);
            __builtin_amdgcn_fence(__ATOMIC_ACQUIRE, "agent");
            asm volatile("s_waitcnt vmcnt(0)" ::: "memory");
        }
    }
    __syncthreads();
}

constexpr int NWAVES = 8;
constexpr int RING_OFF = 0, RING_BYTES = 131072;
constexpr int LDSCTL_OFF = RING_BYTES, MISC_OFF = LDSCTL_OFF + 320;
constexpr int LDS_BYTES = 147456;
constexpr int CW_TMO = 0, CW_CODE = 1, CW_BAR = 4096;
constexpr int NPHASE = 7;
#ifndef MK_N_LAUNCHES
#define MK_N_LAUNCHES 1
#endif

typedef float f32x4 __attribute__((ext_vector_type(4)));
#define LDS_WAIT() asm volatile("s_waitcnt lgkmcnt(0)" ::: "memory")
#define VM_WAIT() asm volatile("s_waitcnt vmcnt(0)" ::: "memory")

struct Args { const float* in[13]; float* out; unsigned char* ws; int ph_lo, ph_hi, li, pad; };
struct TrItem { const float* W; const float* gain; bf16_t* WT; int N, K, k0, n0, sc; };
constexpr int TI_IN = (DM / 64) * (N1P / 256), TI_Q = (QL / 64) * (NQ / 256), TI_KV = (KVL / 64) * (NKV / 256), TI_O = (DM / 64) * (DM / 256);
constexpr int TI_SMALL = TI_Q + TI_KV + 3 * TI_O;
__device__ __forceinline__ TrItem tr_decode(const Args& A, int it, int tid) {
    TrItem r; int i = it; const int np = tid & 255; int nblk, mp;
    if (i < TI_IN) { r.W = A.in[3]; r.gain = nullptr; r.WT = (bf16_t*)(A.ws + WS_WINT); r.N = IN_TOTAL; r.K = DM; nblk = N1P / 256; mp = 1; }
    else { i -= TI_IN;
        if (i < TI_Q) { r.W = A.in[5]; r.gain = A.in[4]; r.WT = (bf16_t*)(A.ws + WS_WQT); r.N = NQ; r.K = QL; nblk = NQ / 256; mp = 2; }
        else { i -= TI_Q;
            if (i < TI_KV) { r.W = A.in[7]; r.gain = A.in[6]; r.WT = (bf16_t*)(A.ws + WS_WKVT); r.N = NKV; r.K = KVL; nblk = NKV / 256; mp = 3; }
            else { i -= TI_KV; const int w = i / TI_O; i -= w * TI_O; r.W = w == 0 ? A.in[9] : w == 1 ? A.in[10] : A.in[11]; r.WT = (bf16_t*)(A.ws + (w == 0 ? WS_WOMT : w == 1 ? WS_WOCT : WS_WOUTT)); r.gain = nullptr; r.N = DM; r.K = DM; nblk = DM / 256; mp = 0; } } }
    const int kb = i / nblk, nb = i - kb * nblk; r.k0 = 64 * kb; r.n0 = 256 * nb;
    r.sc = mp == 1 ? srcmap<1>(r.n0 + np) : mp == 2 ? srcmap<2>(r.n0 + np) : mp == 3 ? srcmap<3>(r.n0 + np) : r.n0 + np;
    return r;
}
__device__ __forceinline__ void tr_load(const TrItem& r, int tid, float (&v)[32]) {
    const int kh = (tid >> 8) * 32;
    if (r.sc >= 0) {
        const GAS float* src = (const GAS float*)r.W + (size_t)(r.k0 + kh) * r.N + r.sc;
#pragma unroll
        for (int i = 0; i < 32; ++i) v[i] = src[(size_t)i * r.N];
    } else {
#pragma unroll
        for (int i = 0; i < 32; ++i) v[i] = 0.f;
    }
}
__device__ __forceinline__ void tr_stream(const Args& T, LAS unsigned char* scr, int first, int stride, int end, int tid) {
    if (first >= end) return;
    float v[32]; int it = first, buf = 0;
    TrItem cur = tr_decode(T, it, tid); tr_load(cur, tid, v);
    for (;;) {
        const int np = tid & 255, kh = (tid >> 8) * 32;
        if (cur.gain) {
#pragma unroll
            for (int i = 0; i < 32; ++i) v[i] *= cur.gain[cur.k0 + kh + i];
        }
        LAS unsigned* row = (LAS unsigned*)(scr + buf * 34816 + np * 136 + kh * 2);
#pragma unroll
        for (int i = 0; i < 16; ++i) row[i] = pk2(v[2 * i], v[2 * i + 1]);
        const int nx = it + stride; const bool more = nx < end;
        TrItem nxt = cur;
        if (more) { nxt = tr_decode(T, nx, tid); tr_load(nxt, tid, v); }
        __syncthreads();
#pragma unroll
        for (int p = 0; p < 4; ++p) { const int r = (tid >> 3) + 64 * p, c = tid & 7;
            const LAS unsigned long long* q = (const LAS unsigned long long*)(scr + buf * 34816 + r * 136 + c * 16);
            const unsigned long long lo = q[0], hi = q[1];
            v4u o; o.x = (unsigned)lo; o.y = (unsigned)(lo >> 32); o.z = (unsigned)hi; o.w = (unsigned)(hi >> 32);
            *(GAS v4u*)(cur.WT + (size_t)(cur.n0 + r) * cur.K + cur.k0 + 8 * c) = o; }
        if (!more) break;
        cur = nxt; it = nx; buf ^= 1;
    }
    __syncthreads();
}

__global__ void __launch_bounds__(NWAVES * 64, 2) mk_fwd(Args args) {
    extern __shared__ __attribute__((aligned(16))) unsigned char lds[];
    LAS unsigned char* ldsp = (LAS unsigned char*)lds;
    volatile LAS unsigned* MISC = (volatile LAS unsigned*)(ldsp + MISC_OFF);
    const int tid = threadIdx.x, lane = tid & 63, wave = __builtin_amdgcn_readfirstlane(tid >> 6);
    const int G = gridDim.x; const int vcu = (G % 8 == 0) ? ((int)blockIdx.x % 8) * (G / 8) + (int)blockIdx.x / 8 : (int)blockIdx.x;
    unsigned char* ws = args.ws;
    unsigned* ctl = (unsigned*)(ws + WS_CTL);
    const float* x = args.in[0]; const int* pos = (const int*)args.in[1]; const float* g_pre = args.in[2]; const float* w_in = args.in[3];
    const float* g_q = args.in[4]; const float* w_qb = args.in[5]; const float* g_kv = args.in[6]; const float* w_kvb = args.in[7];
    const float* conv_w = args.in[8]; const float* w_om = args.in[9]; const float* w_oc = args.in[10]; const float* w_out = args.in[11]; const float* g_post = args.in[12];
    float* ssq = (float*)(ws + WS_SSQ); float2* rope = (float2*)(ws + WS_ROPE);
    bf16_t *WQT = (bf16_t*)(ws + WS_WQT), *WKVT = (bf16_t*)(ws + WS_WKVT), *WOMT = (bf16_t*)(ws + WS_WOMT), *WOCT = (bf16_t*)(ws + WS_WOCT), *WOUTT = (bf16_t*)(ws + WS_WOUTT), *WINT = (bf16_t*)(ws + WS_WINT);
    bf16_t *H = (bf16_t*)(ws + WS_H), *AO = (bf16_t*)(ws + WS_AO), *QA = (bf16_t*)(ws + WS_QA), *CKV = (bf16_t*)(ws + WS_CKV), *KR = (bf16_t*)(ws + WS_KR);
    bf16_t *ZS = (bf16_t*)(ws + WS_ZS), *U = (bf16_t*)(ws + WS_U), *T = (bf16_t*)(ws + WS_T), *SG1 = (bf16_t*)(ws + WS_SG1), *SG2 = (bf16_t*)(ws + WS_SG2);
    bf16_t *QN = (bf16_t*)(ws + WS_QN), *QR = (bf16_t*)(ws + WS_QR), *KN = (bf16_t*)(ws + WS_KN), *V = (bf16_t*)(ws + WS_V), *AC = (bf16_t*)(ws + WS_AC), *MG = (bf16_t*)(ws + WS_MG);
    float* OUTF = (float*)(ws + WS_OUTF);

    for (int u = tid; u < (LDS_BYTES - LDSCTL_OFF) / 4; u += NWAVES * 64) ((LAS unsigned*)(ldsp + LDSCTL_OFF))[u] = 0u;
    __syncthreads();
    const int lo = args.ph_lo, hi = args.ph_hi;
    const bool use_bar = (hi - lo) > 1;
    XcdBarrier bar; bar.bar = ctl + CW_BAR + args.li * XCD_BAR_WORDS; bar.x = 0; bar.st = nullptr;
    if (use_bar) bar = xcd_barrier_post(ctl + CW_BAR + args.li * XCD_BAR_WORDS, MISC + 8);
#ifndef PH_EN
#define PH_EN 0x7F
#endif
#ifndef PROBE_DUP
#define PROBE_DUP -1
#endif
#define REPS(k) for (int rep_ = 0; rep_ < ((PROBE_DUP == (k)) ? 2 : 1); ++rep_)
#define REPBAR(k) do { if (PROBE_DUP == (k) && rep_ == 0) xcd_barrier(bar); } while (0)
#define IN(k) (((PH_EN >> (k)) & 1) && lo <= (k) && (k) < hi)
#define SEAM(k) do { if (lo <= (k) && (k) + 1 < hi) xcd_barrier(bar); } while (0)
    const int gw = vcu * NWAVES + wave, NGW = G * NWAVES;

    if (IN(0)) REPS(0) {
        for (int i = (int)blockIdx.x * (NWAVES * 64) + tid; i < S * 32; i += G * NWAVES * 64) {
            const int s = i >> 5, j = i & 31;
            const float inv = exp2f(-(float)(2 * j) / 64.f * 13.287712379549449f);
            const float ang = (float)pos[s] * inv;
            const double a = (double)ang, kq = rint(a * 0.15915494309189535), r = a - kq * 6.283185307179586;
            const float rf = (float)r;
            rope[i] = make_float2(cosf(rf), sinf(rf));
        }
        for (int m = gw; m < S; m += NGW) {
            const GAS f32x4* xr = (const GAS f32x4*)(x + (size_t)m * DM) + lane;
            f32x4 v[8]; float s = 0.f;
#pragma unroll
            for (int j = 0; j < 8; ++j) { v[j] = xr[64 * j]; s += (v[j].x * v[j].x + v[j].y * v[j].y) + (v[j].z * v[j].z + v[j].w * v[j].w); }
            const float r = rsqrtf(wave_sum(s) * (1.f / DM) + RMS_EPS);
            GAS unsigned long long* o8 = (GAS unsigned long long*)(H + (size_t)m * DM) + lane;
#pragma unroll
            for (int j = 0; j < 8; ++j) { const f32x4 gg = ((const GAS f32x4*)g_pre)[lane + 64 * j];
                o8[64 * j] = (unsigned long long)pk2(v[j].x * r * gg.x, v[j].y * r * gg.y) | ((unsigned long long)pk2(v[j].z * r * gg.z, v[j].w * r * gg.w) << 32); }
        }
        tr_stream(args, ldsp + RING_OFF, vcu, G, TI_IN, tid);
        REPBAR(0);
    }
    SEAM(0);
    if (IN(1)) REPS(1) {
        pg8::Gemm g{H, WINT, S, N1P, DM}; pg8::StaticOrder So; So.init(S, N1P, G, (int)blockIdx.x);
        pg8::EpiP1 E{QA, CKV, KR, ZS, U, T, SG1, SG2, ssq, rope};
        pg8::gemm_phase<pg8::EpiP1, pg8::StaticOrder, true, true>(ldsp + RING_OFF, g, So, E);
        { const int nwg = (S / 256) * (N1P / 256), rem = nwg % G;
          const int first = rem == 0 ? (int)blockIdx.x : (int)blockIdx.x >= rem ? (int)blockIdx.x - rem : TI_SMALL, stride = rem == 0 ? G : G - rem;
          tr_stream(args, ldsp + RING_OFF, TI_IN + first, stride, TI_IN + TI_SMALL, tid); }
        REPBAR(1);
    }
    SEAM(1);
    if (IN(2)) REPS(2) {
        { pg8::Gemm g{QA, WQT, S, NQ, QL}; pg8::StaticOrder So; So.init(S, NQ, G, (int)blockIdx.x);
          pg8::EpiQ E{QN, QR, ssq, rope};
          pg8::gemm_phase<pg8::EpiQ, pg8::StaticOrder, true, true>(ldsp + RING_OFF, g, So, E); }
        { pg8::Gemm g{CKV, WKVT, S, NKV, KVL}; pg8::StaticOrder So; So.init(S, NKV, G, (int)blockIdx.x);
          pg8::EpiKV E{KN, V, ssq};
          pg8::gemm_phase<pg8::EpiKV, pg8::StaticOrder, true, true>(ldsp + RING_OFF, g, So, E); }
        for (size_t i = (size_t)blockIdx.x * (NWAVES * 64) + tid; i < (size_t)S * DM / 8; i += (size_t)G * NWAVES * 64) {
            const int s = (int)(i >> 8), c8 = (int)(i & 255) * 8; const size_t e = (size_t)s * DM + c8;
            f32x4 a0, a1, b0, b1, c0, c1, t0, t1;
            { const v4u q_ = *(const GAS v4u*)(U + e); pg8::unpk8(q_, a0, a1); }
            if (s >= 1) { const v4u q_ = *(const GAS v4u*)(U + e - DM); pg8::unpk8(q_, b0, b1); } else { b0 = (f32x4){0.f, 0.f, 0.f, 0.f}; b1 = b0; }
            if (s >= 2) { const v4u q_ = *(const GAS v4u*)(U + e - 2 * DM); pg8::unpk8(q_, c0, c1); } else { c0 = (f32x4){0.f, 0.f, 0.f, 0.f}; c1 = c0; }
            { const v4u q_ = *(const GAS v4u*)(T + e); pg8::unpk8(q_, t0, t1); }
            const f32x4 w00 = *(const GAS f32x4*)(conv_w + c8), w01 = *(const GAS f32x4*)(conv_w + c8 + 4);
            const f32x4 w10 = *(const GAS f32x4*)(conv_w + DM + c8), w11 = *(const GAS f32x4*)(conv_w + DM + c8 + 4);
            const f32x4 w20 = *(const GAS f32x4*)(conv_w + 2 * DM + c8), w21 = *(const GAS f32x4*)(conv_w + 2 * DM + c8 + 4);
            const f32x4 r0 = t0 * (w00 * c0 + w10 * b0 + w20 * a0), r1 = t1 * (w01 * c1 + w11 * b1 + w21 * a1);
            v4u o; o.x = pk2(r0[0], r0[1]); o.y = pk2(r0[2], r0[3]); o.z = pk2(r1[0], r1[1]); o.w = pk2(r1[2], r1[3]);
            *(GAS v4u*)(AC + e) = o;
        }
        REPBAR(2);
    }
    SEAM(2);
    if (IN(3)) REPS(3) {
        att::Tens AT{QN, QR, KN, KR, V, ZS, AO};
        att::attn_phase(AT, (char*)lds + RING_OFF);
        REPBAR(3);
    }
    SEAM(3);
    if (IN(4)) REPS(4) {
        pg8::Gemm g{AO, WOMT, S, DM, DM, AC, WOCT}; pg8::StaticOrder So; So.init(S, DM, G, (int)blockIdx.x);
        pg8::EpiMerge E{SG1, SG2, MG};
        pg8::gemm_phase<pg8::EpiMerge, pg8::StaticOrder, true, true>(ldsp + RING_OFF, g, So, E);
        REPBAR(4);
    }
    SEAM(4);
    if (IN(5)) REPS(5) {
        pg8::Gemm g{MG, WOUTT, S, DM, DM}; pg8::StaticOrder So; So.init(S, DM, G, (int)blockIdx.x);
        pg8::EpiOut E{OUTF};
        pg8::gemm_phase<pg8::EpiOut, pg8::StaticOrder, true, true>(ldsp + RING_OFF, g, So, E);
        REPBAR(5);
    }
    SEAM(5);
    if (IN(6)) REPS(6) {
        for (int m = gw; m < S; m += NGW) {
            const GAS f32x4* yr = (const GAS f32x4*)(OUTF + (size_t)m * DM) + lane; const GAS f32x4* xr = (const GAS f32x4*)(x + (size_t)m * DM) + lane;
            f32x4 v[8]; float s = 0.f;
#pragma unroll
            for (int j = 0; j < 8; ++j) { v[j] = yr[64 * j]; s += (v[j].x * v[j].x + v[j].y * v[j].y) + (v[j].z * v[j].z + v[j].w * v[j].w); }
            const float r = rsqrtf(wave_sum(s) * (1.f / DM) + RMS_EPS);
            GAS f32x4* orow = (GAS f32x4*)(args.out + (size_t)m * DM) + lane;
#pragma unroll
            for (int j = 0; j < 8; ++j) { const f32x4 gg = ((const GAS f32x4*)g_post)[lane + 64 * j]; orow[64 * j] = xr[64 * j] + v[j] * r * gg; }
        }
        REPBAR(6);
    }
#undef IN
#undef SEAM
}

__global__ void __launch_bounds__(256) k_prep_misc(const int* pos, float2* rope, float* ssq) {
    const int i = blockIdx.x * 256 + threadIdx.x;
    if (i < S * 32) {
        const int s = i >> 5, j = i & 31;
        const float inv = exp2f(-(float)(2 * j) / 64.f * 13.287712379549449f);
        const float ang = (float)pos[s] * inv;
        const double a = (double)ang;
        const double k = rint(a * 0.15915494309189535);
        const double r = a - k * 6.283185307179586;
        const float rf = (float)r;
        rope[i] = make_float2(cosf(rf), sinf(rf));
    }
    if (i < S * 2) ssq[i] = 0.f;
}
__global__ void __launch_bounds__(256) k_xnorm(const float* x, const float* g, bf16_t* H) {
    const int row = blockIdx.x * 4 + (threadIdx.x >> 6), lane = threadIdx.x & 63;
    const float4* xr = (const float4*)(x + (size_t)row * DM);
    float4 v[8]; float s = 0.f;
#pragma unroll
    for (int j = 0; j < 8; ++j) { v[j] = xr[lane + 64 * j]; s += v[j].x * v[j].x + v[j].y * v[j].y + v[j].z * v[j].z + v[j].w * v[j].w; }
    const float r = rsqrtf(wave_sum(s) * (1.f / DM) + RMS_EPS);
#pragma unroll
    for (int j = 0; j < 8; ++j) {
        const float4 gg = ((const float4*)g)[lane + 64 * j];
        ushort4 o; o.x = f2bf(v[j].x * r * gg.x); o.y = f2bf(v[j].y * r * gg.y); o.z = f2bf(v[j].z * r * gg.z); o.w = f2bf(v[j].w * r * gg.w);
        ((ushort4*)(H + (size_t)row * DM))[lane + 64 * j] = o;
    }
}

template <int ND, class F>
__global__ void __launch_bounds__(256) nv_dots(F f) {
    const int c = blockIdx.x * 256 + threadIdx.x, r0 = blockIdx.y * 8;
    const bool act = c < f.ncols; const int cc = act ? c : 0;
    float acc[ND][8];
#pragma unroll
    for (int d = 0; d < ND; ++d)
#pragma unroll
        for (int i = 0; i < 8; ++i) acc[d][i] = 0.f;
    int wc[ND];
#pragma unroll
    for (int d = 0; d < ND; ++d) wc[d] = f.wcol(d, cc);
    for (int k = 0; k < f.K; k += 8) {
        float a[8][8];
#pragma unroll
        for (int i = 0; i < 8; ++i) {
            const v4u q = *(const v4u*)(f.A + (size_t)(r0 + i) * f.lda + k);
#pragma unroll
            for (int e = 0; e < 4; ++e) { a[i][2 * e] = __uint_as_float(q[e] << 16); a[i][2 * e + 1] = __uint_as_float(q[e] & 0xffff0000u); }
        }
#pragma unroll
        for (int e = 0; e < 8; ++e) {
            const float gk = f.gain ? f.gain[k + e] : 1.f;
#pragma unroll
            for (int d = 0; d < ND; ++d) {
                const float w = f.W[(size_t)(k + e) * f.ldw + wc[d]] * gk;
#pragma unroll
                for (int i = 0; i < 8; ++i) acc[d][i] = fmaf(a[i][e], w, acc[d][i]);
            }
        }
    }
#pragma unroll
    for (int i = 0; i < 8; ++i) { float v[ND];
#pragma unroll
        for (int d = 0; d < ND; ++d) v[d] = acc[d][i];
        f.out(r0 + i, cc, v, act); }
}
struct FBase { const bf16_t* A; int lda; const float* W; int ldw; const float* gain; int K; int ncols; };
struct F_LAT : FBase { int cbase; bf16_t* dst; float* ssq; int which;
    __device__ int wcol(int, int c) const { return cbase + c; }
    __device__ void out(int row, int c, const float (&v)[1], bool) const { dst[(size_t)row * 512 + c] = f2bf(v[0]); const float s = wave_sum(v[0] * v[0]); if ((threadIdx.x & 63) == 0) atomicAdd(ssq + row * 2 + which, s); } };
struct F_KR : FBase { bf16_t* dst; const float2* rope;
    __device__ int wcol(int d, int c) const { return C_KR + 32 * d + c; }
    __device__ void out(int row, int c, const float (&v)[2], bool act) const { if (!act) return; const float2 cs = rope[row * 32 + c];
        dst[(size_t)row * 64 + c] = f2bf(v[0] * cs.x - v[1] * cs.y); dst[(size_t)row * 64 + 32 + c] = f2bf(v[0] * cs.y + v[1] * cs.x); } };
struct F_ACT : FBase { int cbase; bf16_t* dst; int mode;
    __device__ int wcol(int, int c) const { return cbase + c; }
    __device__ void out(int row, int c, const float (&v)[1], bool) const { dst[(size_t)row * DM + c] = f2bf(mode == 0 ? silu_f(v[0]) : sigm_f(v[0])); } };
struct F_CV : FBase { bf16_t* U; bf16_t* T;
    __device__ int wcol(int d, int c) const { return (d == 0 ? C_CIN : d == 1 ? C_BG : d == 2 ? C_CG : C_ZC) + c; }
    __device__ void out(int row, int c, const float (&v)[4], bool) const { U[(size_t)row * DM + c] = f2bf(v[2] * v[0]); T[(size_t)row * DM + c] = f2bf(v[1] * silu_f(v[3])); } };
struct F_QN : FBase { bf16_t* dst; const float* ssq;
    __device__ int wcol(int, int c) const { return 192 * (c >> 7) + (c & 127); }
    __device__ void out(int row, int c, const float (&v)[1], bool) const { const float r = rsqrtf(ssq[row * 2] * (1.f / QL) + RMS_EPS); dst[(size_t)row * 2048 + c] = f2bf(v[0] * r * QSCALE); } };
struct F_QR : FBase { bf16_t* dst; const float* ssq; const float2* rope;
    __device__ int wcol(int d, int c) const { return 192 * (c >> 5) + 128 + 32 * d + (c & 31); }
    __device__ void out(int row, int c, const float (&v)[2], bool) const { const float r = rsqrtf(ssq[row * 2] * (1.f / QL) + RMS_EPS) * QSCALE; const float2 cs = rope[row * 32 + (c & 31)];
        const int h = c >> 5, i = c & 31; const float x1 = v[0] * r, x2 = v[1] * r;
        dst[(size_t)row * 1024 + 64 * h + i] = f2bf(x1 * cs.x - x2 * cs.y); dst[(size_t)row * 1024 + 64 * h + 32 + i] = f2bf(x1 * cs.y + x2 * cs.x); } };
struct F_KV : FBase { bf16_t* dst; const float* ssq; int off;
    __device__ int wcol(int, int c) const { return 256 * (c >> 7) + off + (c & 127); }
    __device__ void out(int row, int c, const float (&v)[1], bool) const { const float r = rsqrtf(ssq[row * 2 + 1] * (1.f / KVL) + RMS_EPS); dst[(size_t)row * 2048 + c] = f2bf(v[0] * r); } };
struct F_Y1 : FBase { float* tmp; const bf16_t* sg;
    __device__ int wcol(int, int c) const { return c; }
    __device__ void out(int row, int c, const float (&v)[1], bool) const { tmp[(size_t)row * DM + c] = v[0] * bf2f(sg[(size_t)row * DM + c]); } };
struct F_Y2 : FBase { const float* tmp; const bf16_t* sg; bf16_t* mg;
    __device__ int wcol(int, int c) const { return c; }
    __device__ void out(int row, int c, const float (&v)[1], bool) const { mg[(size_t)row * DM + c] = f2bf(tmp[(size_t)row * DM + c] + v[0] * bf2f(sg[(size_t)row * DM + c])); } };
struct F_OUT : FBase { float* outf;
    __device__ int wcol(int, int c) const { return c; }
    __device__ void out(int row, int c, const float (&v)[1], bool) const { outf[(size_t)row * DM + c] = v[0]; } };

__global__ void __launch_bounds__(256) k_conv(const bf16_t* U, const bf16_t* T, const float* cw, bf16_t* AC) {
    const size_t i = (size_t)blockIdx.x * 256 + threadIdx.x;
    const int s = (int)(i / DM), c = (int)(i % DM);
    const float u0 = bf2f(U[i]), u1 = s >= 1 ? bf2f(U[i - DM]) : 0.f, u2 = s >= 2 ? bf2f(U[i - 2 * DM]) : 0.f;
    const float cv = cw[c] * u2 + cw[DM + c] * u1 + cw[2 * DM + c] * u0;
    AC[i] = f2bf(bf2f(T[i]) * cv);
}

constexpr int NA_LDS = (64 * 193 * 2 + 64 * 132 + 64 * 65) * 4;
__global__ void __launch_bounds__(256) nv_attn(const bf16_t* QN, const bf16_t* QR, const bf16_t* KN, const bf16_t* KR, const bf16_t* V, const bf16_t* ZS, bf16_t* AO) {
    extern __shared__ __attribute__((aligned(16))) float sm[];
    float* Qs = sm; float* Ks = Qs + 64 * 193; float* Vs = Ks + 64 * 193; float* Ps = Vs + 64 * 132;
    const int qb = blockIdx.x, h = blockIdx.y, tid = threadIdx.x, r = tid >> 2, qq = tid & 3, q0 = qb * 64;
    for (int i = tid; i < 64 * 192; i += 256) { const int rr = i / 192, d = i % 192;
        Qs[rr * 193 + d] = d < 128 ? bf2f(QN[(size_t)(q0 + rr) * 2048 + h * 128 + d]) : bf2f(QR[(size_t)(q0 + rr) * 1024 + h * 64 + d - 128]); }
    float m = -1e30f, l = 0.f, o[32];
#pragma unroll
    for (int d = 0; d < 32; ++d) o[d] = 0.f;
    for (int kt = 0; kt <= qb; ++kt) {
        __syncthreads();
        const int k0 = kt * 64;
        for (int i = tid; i < 64 * 192; i += 256) { const int rr = i / 192, d = i % 192;
            Ks[rr * 193 + d] = d < 128 ? bf2f(KN[(size_t)(k0 + rr) * 2048 + h * 128 + d]) : bf2f(KR[(size_t)(k0 + rr) * 64 + d - 128]); }
        for (int i = tid; i < 64 * 128; i += 256) { const int rr = i >> 7, d = i & 127; Vs[rr * 132 + (d >> 5) * 33 + (d & 31)] = bf2f(V[(size_t)(k0 + rr) * 2048 + h * 128 + d]); }
        __syncthreads();
        float s[16]; float mx = -INFINITY;
#pragma unroll
        for (int j = 0; j < 16; ++j) { const int key = 4 * j + qq; float a = 0.f;
            for (int d = 0; d < 192; ++d) a = fmaf(Qs[r * 193 + d], Ks[key * 193 + d], a);
            if (k0 + key > q0 + r) a = -INFINITY;
            s[j] = a; mx = fmaxf(mx, a); }
        mx = fmaxf(mx, __shfl_xor(mx, 1)); mx = fmaxf(mx, __shfl_xor(mx, 2));
        const float mn = fmaxf(m, mx), alpha = exp2f(m - mn); m = mn;
        float ps = 0.f;
#pragma unroll
        for (int j = 0; j < 16; ++j) { const float p = exp2f(s[j] - mn); ps += p; Ps[r * 65 + 4 * j + qq] = p; }
        ps += __shfl_xor(ps, 1); ps += __shfl_xor(ps, 2);
        l = l * alpha + ps;
        __syncthreads();
#pragma unroll
        for (int d = 0; d < 32; ++d) o[d] *= alpha;
        for (int key = 0; key < 64; ++key) { const float p = Ps[r * 65 + key];
#pragma unroll
            for (int d = 0; d < 32; ++d) o[d] = fmaf(p, Vs[key * 132 + qq * 33 + d], o[d]); }
    }
    const float li = 1.f / l;
#pragma unroll
    for (int d = 0; d < 32; ++d) { const size_t idx = (size_t)(q0 + r) * 2048 + h * 128 + qq * 32 + d; AO[idx] = f2bf(o[d] * li * bf2f(ZS[idx])); }
}

__global__ void __launch_bounds__(256) k_final(const float* x, const float* outf, const float* g, float* out) {
    const int row = blockIdx.x * 4 + (threadIdx.x >> 6), lane = threadIdx.x & 63;
    const float4* yr = (const float4*)(outf + (size_t)row * DM); const float4* xr = (const float4*)(x + (size_t)row * DM);
    float4 v[8]; float s = 0.f;
#pragma unroll
    for (int j = 0; j < 8; ++j) { v[j] = yr[lane + 64 * j]; s += v[j].x * v[j].x + v[j].y * v[j].y + v[j].z * v[j].z + v[j].w * v[j].w; }
    const float r = rsqrtf(wave_sum(s) * (1.f / DM) + RMS_EPS);
#pragma unroll
    for (int j = 0; j < 8; ++j) { const float4 gg = ((const float4*)g)[lane + 64 * j], xx = xr[lane + 64 * j];
        float4 o; o.x = xx.x + v[j].x * r * gg.x; o.y = xx.y + v[j].y * r * gg.y; o.z = xx.z + v[j].z * r * gg.z; o.w = xx.w + v[j].w * r * gg.w;
        ((float4*)(out + (size_t)row * DM))[lane + 64 * j] = o; }
}


template <int ND, class F> static void run_dots(const F& f, hipStream_t st) {
    hipLaunchKernelGGL((nv_dots<ND, F>), dim3((f.ncols + 255) / 256, S / 8), dim3(256), 0, st, f);
}
#ifndef IMPL_MASK
#define IMPL_MASK 0x7F
#endif
extern "C" void kernel_launch(void* const* d_in, const int* in_sizes, int n_in, void* d_out, int out_size, void* d_ws, size_t ws_size, hipStream_t stream) {
    static int grid = 0;
    if (grid == 0) {
        if (n_in != 13 || in_sizes[0] != S * DM || in_sizes[3] != DM * IN_TOTAL || out_size != S * DM || ws_size < WS_END) {
            fprintf(stderr, "kernel_launch: unexpected shapes / workspace (n_in %d, ws %zu, need %zu)\n", n_in, ws_size, (size_t)WS_END); grid = -1; return; }
        int dev = 0, cus = 0, per_cu = 0;
        if (hipGetDevice(&dev) != hipSuccess || hipDeviceGetAttribute(&cus, hipDeviceAttributeMultiprocessorCount, dev) != hipSuccess) { grid = -1; return; }
        if (hipFuncSetAttribute((const void*)mk_fwd, hipFuncAttributeMaxDynamicSharedMemorySize, LDS_BYTES) != hipSuccess) { fprintf(stderr, "kernel_launch: hipFuncSetAttribute failed\n"); grid = -1; return; }
        (void)hipFuncSetAttribute((const void*)nv_attn, hipFuncAttributeMaxDynamicSharedMemorySize, NA_LDS);
        if (hipOccupancyMaxActiveBlocksPerMultiprocessor(&per_cu, (const void*)mk_fwd, NWAVES * 64, LDS_BYTES) != hipSuccess || per_cu < 1) { fprintf(stderr, "kernel_launch: occupancy query says %d\n", per_cu); per_cu = 1; }
        (void)hipGetLastError();
        grid = cus * 1;
        if (per_cu < 1) grid = -1;
    }
    if (grid < 0) return;
    if (hipMemsetAsync((char*)d_ws + WS_CTL, 0, CTL_ZERO_BYTES, stream) != hipSuccess) { fprintf(stderr, "kernel_launch: memset failed\n"); return; }
    Args a; memset(&a, 0, sizeof a);
    for (int i = 0; i < 13; ++i) a.in[i] = (const float*)d_in[i];
    a.out = (float*)d_out; a.ws = (unsigned char*)d_ws;
    if (MK_N_LAUNCHES == 1 && (IMPL_MASK & 0x7F) == 0x7F) {
        a.ph_lo = 0; a.ph_hi = NPHASE; a.li = 0;
        void* kargs[] = {&a};
        hipError_t e = hipLaunchCooperativeKernel((const void*)mk_fwd, dim3(grid), dim3(NWAVES * 64), kargs, LDS_BYTES, stream);
        if (e != hipSuccess) fprintf(stderr, "kernel_launch: cooperative launch failed: %s (grid %d)\n", hipGetErrorString(e), grid);
        return;
    }
    const float* x = (const float*)d_in[0]; const int* pos = (const int*)d_in[1]; const float* g_pre = (const float*)d_in[2]; const float* w_in = (const float*)d_in[3];
    const float* g_q = (const float*)d_in[4]; const float* w_qb = (const float*)d_in[5]; const float* g_kv = (const float*)d_in[6]; const float* w_kvb = (const float*)d_in[7];
    const float* conv_w = (const float*)d_in[8]; const float* w_om = (const float*)d_in[9]; const float* w_oc = (const float*)d_in[10]; const float* w_out = (const float*)d_in[11];
    const float* g_post = (const float*)d_in[12];
    unsigned char* ws = (unsigned char*)d_ws;
    float* ssq = (float*)(ws + WS_SSQ); float2* rope = (float2*)(ws + WS_ROPE);
    bf16_t *H = (bf16_t*)(ws + WS_H), *AO = (bf16_t*)(ws + WS_AO), *QA = (bf16_t*)(ws + WS_QA), *CKV = (bf16_t*)(ws + WS_CKV), *KR = (bf16_t*)(ws + WS_KR);
    bf16_t *ZS = (bf16_t*)(ws + WS_ZS), *U = (bf16_t*)(ws + WS_U), *T = (bf16_t*)(ws + WS_T), *SG1 = (bf16_t*)(ws + WS_SG1), *SG2 = (bf16_t*)(ws + WS_SG2);
    bf16_t *QN = (bf16_t*)(ws + WS_QN), *QR = (bf16_t*)(ws + WS_QR), *KN = (bf16_t*)(ws + WS_KN), *V = (bf16_t*)(ws + WS_V), *AC = (bf16_t*)(ws + WS_AC), *MG = (bf16_t*)(ws + WS_MG);
    float* OUTF = (float*)(ws + WS_OUTF);
    for (int k = 0; k < NPHASE; ++k) {
        if ((IMPL_MASK >> k) & 1) { a.ph_lo = k; a.ph_hi = k + 1; a.li = 0; hipLaunchKernelGGL(mk_fwd, dim3(grid), dim3(NWAVES * 64), LDS_BYTES, stream, a); continue; }
        switch (k) {
        case 0: hipLaunchKernelGGL(k_prep_misc, dim3(S * 32 / 256), dim3(256), 0, stream, pos, rope, ssq + S * 2);
                hipLaunchKernelGGL(k_xnorm, dim3(S / 4), dim3(256), 0, stream, x, g_pre, H); break;
        case 1: { { F_LAT f; memset(&f, 0, sizeof f); f.A = H; f.lda = DM; f.W = w_in; f.ldw = IN_TOTAL; f.gain = nullptr; f.K = DM; f.ncols = 512; f.cbase = C_QA; f.dst = QA; f.ssq = ssq; f.which = 0; run_dots<1>(f, stream);
                    f.cbase = C_CKV; f.dst = CKV; f.which = 1; run_dots<1>(f, stream); }
                  { F_KR f; memset(&f, 0, sizeof f); f.A = H; f.lda = DM; f.W = w_in; f.ldw = IN_TOTAL; f.gain = nullptr; f.K = DM; f.ncols = 32; f.dst = KR; f.rope = rope; run_dots<2>(f, stream); }
                  { F_ACT f; memset(&f, 0, sizeof f); f.A = H; f.lda = DM; f.W = w_in; f.ldw = IN_TOTAL; f.gain = nullptr; f.K = DM; f.ncols = DM; f.cbase = C_ZM; f.dst = ZS; f.mode = 0; run_dots<1>(f, stream);
                    f.cbase = C_GM; f.dst = SG1; f.mode = 1; run_dots<1>(f, stream);
                    f.cbase = C_GC; f.dst = SG2; f.mode = 1; run_dots<1>(f, stream); }
                  { F_CV f; memset(&f, 0, sizeof f); f.A = H; f.lda = DM; f.W = w_in; f.ldw = IN_TOTAL; f.gain = nullptr; f.K = DM; f.ncols = DM; f.U = U; f.T = T; run_dots<4>(f, stream); } } break;
        case 2: { { F_QN f; memset(&f, 0, sizeof f); f.A = QA; f.lda = QL; f.W = w_qb; f.ldw = 3072; f.gain = g_q; f.K = QL; f.ncols = 2048; f.dst = QN; f.ssq = ssq; run_dots<1>(f, stream); }
                  { F_QR f; memset(&f, 0, sizeof f); f.A = QA; f.lda = QL; f.W = w_qb; f.ldw = 3072; f.gain = g_q; f.K = QL; f.ncols = 512; f.dst = QR; f.ssq = ssq; f.rope = rope; run_dots<2>(f, stream); }
                  { F_KV f; memset(&f, 0, sizeof f); f.A = CKV; f.lda = KVL; f.W = w_kvb; f.ldw = 4096; f.gain = g_kv; f.K = KVL; f.ncols = 2048; f.dst = KN; f.ssq = ssq; f.off = 0; run_dots<1>(f, stream);
                    f.dst = V; f.off = 128; run_dots<1>(f, stream); }
                  hipLaunchKernelGGL(k_conv, dim3(S * DM / 256), dim3(256), 0, stream, U, T, conv_w, AC); } break;
        case 3: hipLaunchKernelGGL(nv_attn, dim3(S / 64, NH), dim3(256), NA_LDS, stream, QN, QR, KN, KR, V, ZS, AO); break;
        case 4: { { F_Y1 f; memset(&f, 0, sizeof f); f.A = AO; f.lda = DM; f.W = w_om; f.ldw = DM; f.gain = nullptr; f.K = DM; f.ncols = DM; f.tmp = OUTF; f.sg = SG1; run_dots<1>(f, stream); }
                  { F_Y2 f; memset(&f, 0, sizeof f); f.A = AC; f.lda = DM; f.W = w_oc; f.ldw = DM; f.gain = nullptr; f.K = DM; f.ncols = DM; f.tmp = OUTF; f.sg = SG2; f.mg = MG; run_dots<1>(f, stream); } } break;
        case 5: { F_OUT f; memset(&f, 0, sizeof f); f.A = MG; f.lda = DM; f.W = w_out; f.ldw = DM; f.gain = nullptr; f.K = DM; f.ncols = DM; f.outf = OUTF; run_dots<1>(f, stream); } break;
        default: hipLaunchKernelGGL(k_final, dim3(S / 4), dim3(256), 0, stream, x, OUTF, g_post, (float*)d_out); break;
        }
    }
}
```

```cpp
#define MK_N_LAUNCHES 1
#include <hip/hip_runtime.h>
#include <cstdio>
#include <cstdint>
#include <cstring>

constexpr int S = 8192, DM = 2048, NH = 16, QL = 512, KVL = 512;
constexpr int IN_TOTAL = 15424;
constexpr int C_QA = 0, C_CKV = 512, C_KR = 1024, C_ZM = 1088, C_CIN = 3136, C_BG = 5184, C_CG = 7232, C_ZC = 9280, C_GM = 11328, C_GC = 13376;
constexpr int N1P = 61 * 256;
constexpr int NQ = 3072, NKV = 4096;
constexpr float RMS_EPS = 1e-6f;
constexpr float QSCALE = 0.07216878364870322f * 1.4426950408889634f;

constexpr size_t MiB = 1u << 20;
constexpr size_t WS_CTL = 0, CTL_ZERO_BYTES = 1 * MiB;
constexpr size_t WS_SSQ = 512 * 1024;
constexpr size_t WS_ROPE = 2 * MiB;
constexpr size_t WS_WQT = 4 * MiB, WS_WKVT = 7 * MiB, WS_WOMT = 11 * MiB, WS_WOCT = 19 * MiB, WS_WOUTT = 27 * MiB, WS_WINT = 35 * MiB;
constexpr size_t WS_H = 96 * MiB;
constexpr size_t WS_AO = WS_H;
constexpr size_t WS_QA = 128 * MiB, WS_CKV = 136 * MiB, WS_KR = 144 * MiB;
constexpr size_t WS_ZS = 146 * MiB, WS_U = 178 * MiB, WS_T = 210 * MiB, WS_SG1 = 242 * MiB, WS_SG2 = 274 * MiB;
constexpr size_t WS_QN = 306 * MiB, WS_QR = 338 * MiB, WS_KN = 354 * MiB, WS_V = 386 * MiB;
constexpr size_t WS_AC = 418 * MiB, WS_END = 450 * MiB;
constexpr size_t WS_MG = WS_U;
constexpr size_t WS_OUTF = WS_QN;
static_assert(WS_WINT + (size_t)N1P * DM * 2 <= WS_H, "ws map");

typedef unsigned short bf16_t;
typedef unsigned v4u __attribute__((ext_vector_type(4)));
#define GAS __attribute__((address_space(1)))
#define LAS __attribute__((address_space(3)))
__device__ __forceinline__ float bf2f(bf16_t v) { return __uint_as_float((unsigned)v << 16); }
__device__ __forceinline__ bf16_t f2bf(float f) { unsigned u = __float_as_uint(f); return (bf16_t)((u + 0x7fffu + ((u >> 16) & 1u)) >> 16); }
__device__ __forceinline__ unsigned pk2(float lo, float hi) { return (unsigned)f2bf(lo) | ((unsigned)f2bf(hi) << 16); }
__device__ __forceinline__ float silu_f(float v) { return v / (1.f + expf(-v)); }
__device__ __forceinline__ float sigm_f(float v) { return 1.f / (1.f + expf(-v)); }
__device__ __forceinline__ float fsigm(float v) { return __builtin_amdgcn_rcpf(1.f + __builtin_amdgcn_exp2f(-1.4426950408889634f * v)); }
__device__ __forceinline__ float wave_sum(float v) {
#pragma unroll
    for (int o = 1; o < 64; o <<= 1) v += __shfl_xor(v, o);
    return v;
}
template <int MAP> __device__ __forceinline__ int srcmap(int np) {
    if (MAP == 1) {
        const int t = np >> 8, c = np & 255;
        if (t < 4) return np;
        if (t == 4) return (c & 127) < 32 ? C_KR + 32 * (c >> 7) + (c & 127) : -1;
        if (t < 13) return C_ZM + np - 5 * 256;
        if (t < 45) { const int tt = t - 13, kind = 2 * (c >> 7) + ((c >> 2) & 1), ch = 64 * tt + 4 * ((c & 127) >> 3) + (c & 3);
            return (kind == 0 ? C_CIN : kind == 1 ? C_BG : kind == 2 ? C_CG : C_ZC) + ch; }
        if (t < 53) return C_GM + np - 45 * 256;
        return C_GC + np - 53 * 256;
    }
    if (MAP == 2) {
        if (np < 2048) return 192 * (np >> 7) + (np & 127);
        const int t = (np - 2048) >> 8, c = np & 255, head = 4 * t + ((c & 127) >> 5);
        return 192 * head + 128 + 32 * (c >> 7) + (c & 31);
    }
    if (MAP == 3) { const int h = (np & 2047) >> 7, d = np & 127; return 256 * h + (np >= 2048 ? 128 : 0) + d; }
    return np;
}

namespace pg8 {
#define PG8_LAS __attribute__((address_space(3)))
typedef unsigned short bf16_t;
typedef short bf16x8 __attribute__((ext_vector_type(8)));
typedef float f32x4 __attribute__((ext_vector_type(4)));
typedef unsigned u32x4 __attribute__((ext_vector_type(4)));
constexpr int BM = 256, BK = 64, HALF = 128, HTB = HALF * BK * 2  , STAGE_BYTES = 8 * HTB, NXCD = 8, WGM = 8;

__host__ __device__ __forceinline__ int lds_byte(int r, int c) { const int st = (r >> 4) * 2 + (c >> 5), rr = r & 15, cc = c & 31, ob = rr * 64 + cc * 2; return st * 1024 + (ob ^ (((ob >> 9) & 1) << 5)); }
__host__ __device__ __forceinline__ void stage_rc(int b, int& R, int& C) { const int st = b / 1024, sb = b % 1024, swz = sb ^ (((sb >> 9) & 1) << 5); R = (st >> 1) * 16 + swz / 64; C = (st & 1) * 32 + (swz % 64) / 2; }
__host__ __device__ __forceinline__ int perm32(int rho) { const int n = rho >> 4, i = rho & 15; return 8 * (i >> 2) + 4 * n + (i & 3); }

struct Unit { int pm, pn; };
struct Gemm { const bf16_t* A; const bf16_t* Bt; int M, N, K; const bf16_t* A2; const bf16_t* Bt2; };

struct StaticOrder {
    int nM, nN, nwg, G, c;
    __host__ __device__ void init(int M, int N, int G_, int c_) { nM = M / BM; nN = N / BM; nwg = nM * nN; G = G_; c = c_; }
    __host__ __device__ bool next(int i, Unit& u) const {
        const long L = (long)i * G + c; if (L >= nwg) return false;
        int wgid = (int)L; { const int q = nwg / NXCD, r = nwg % NXCD, xcd = wgid % NXCD, off = wgid / NXCD; wgid = (xcd < r ? xcd * (q + 1) : r * (q + 1) + (xcd - r) * q) + off; }
        const int nig = WGM * nN, gid = wgid / nig, fm = gid * WGM, gsz = (nM - fm) < WGM ? (nM - fm) : WGM;
        u.pm = fm + ((wgid % nig) % gsz); u.pn = (wgid % nig) / gsz; return true;
    }
    __device__ __forceinline__ void a_ready(const Unit&) const {}
    __device__ __forceinline__ void done(const Unit&) const {}
};

__device__ __forceinline__ unsigned cvt_pk_bf16(float lo, float hi) { unsigned r; asm volatile("v_cvt_pk_bf16_f32 %0, %1, %2" : "=v"(r) : "v"(lo), "v"(hi)); return r; }
typedef float f32x2 __attribute__((ext_vector_type(2)));

__device__ __forceinline__ u32x4 pk8(const f32x4& a, const f32x4& b) { u32x4 w; w.x = cvt_pk_bf16(a[0], a[1]); w.y = cvt_pk_bf16(a[2], a[3]); w.z = cvt_pk_bf16(b[0], b[1]); w.w = cvt_pk_bf16(b[2], b[3]); return w; }
__device__ __forceinline__ float fsig(float v) { return __builtin_amdgcn_rcpf(1.f + __builtin_amdgcn_exp2f(-1.4426950408889634f * v)); }
__device__ __forceinline__ f32x4 sig4(const f32x4& v) { return (f32x4){fsig(v[0]), fsig(v[1]), fsig(v[2]), fsig(v[3])}; }
__device__ __forceinline__ f32x4 silu4(const f32x4& v) { return v * sig4(v); }
struct EpiP1 {
    static constexpr bool PERM = true, AFTER_DRAIN = false, HAS_MID = false;
    bf16_t *QA, *CKV, *KR, *ZS, *U, *T, *SG1, *SG2; float* ssq; const float2* rope;
    __device__ __forceinline__ void operator()(const f32x4 (&acc)[2][2][4][2], const Unit& u, int wr, int wc, int fr, int fq) const {
        const int pn = u.pn, row0 = u.pm * BM + wr * 64 + fr, cg = wc * 4 + fq;
        if (pn < 4) {
            bf16_t* dst = (pn < 2 ? QA : CKV) + (pn & 1) * 256 + 8 * cg; const int which = pn >> 1;
#pragma unroll
            for (int ai = 0; ai < 2; ++ai)
#pragma unroll
                for (int m = 0; m < 4; ++m) { const int row = row0 + ai * HALF + m * 16; float ss = 0.f;
#pragma unroll
                    for (int bj = 0; bj < 2; ++bj) { const f32x4 v0 = acc[ai][bj][m][0], v1 = acc[ai][bj][m][1];
                        *(u32x4*)(dst + (size_t)row * 512 + bj * HALF) = pk8(v0, v1);
                        ss += (v0[0] * v0[0] + v0[1] * v0[1]) + (v0[2] * v0[2] + v0[3] * v0[3]) + (v1[0] * v1[0] + v1[1] * v1[1]) + (v1[2] * v1[2] + v1[3] * v1[3]); }
                    ss += __shfl_xor(ss, 16); ss += __shfl_xor(ss, 32);
                    if (fq == 0) atomicAdd(ssq + row * 2 + which, ss); }
        } else if (pn == 4) {
            if (wc == 0) {
#pragma unroll
                for (int ai = 0; ai < 2; ++ai)
#pragma unroll
                    for (int m = 0; m < 4; ++m) { const int row = row0 + ai * HALF + m * 16; const f32x4* cs = (const f32x4*)(rope + (size_t)row * 32 + 8 * fq);
                        f32x4 o1[2], o2[2];
#pragma unroll
                        for (int n = 0; n < 2; ++n) { const f32x4 x1 = acc[ai][0][m][n], x2 = acc[ai][1][m][n]; const f32x4 c01 = cs[2 * n], c23 = cs[2 * n + 1];
                            o1[n] = (f32x4){x1[0] * c01[0] - x2[0] * c01[1], x1[1] * c01[2] - x2[1] * c01[3], x1[2] * c23[0] - x2[2] * c23[1], x1[3] * c23[2] - x2[3] * c23[3]};
                            o2[n] = (f32x4){x1[0] * c01[1] + x2[0] * c01[0], x1[1] * c01[3] + x2[1] * c01[2], x1[2] * c23[1] + x2[2] * c23[0], x1[3] * c23[3] + x2[3] * c23[2]}; }
                        *(u32x4*)(KR + (size_t)row * 64 + 8 * fq) = pk8(o1[0], o1[1]); *(u32x4*)(KR + (size_t)row * 64 + 32 + 8 * fq) = pk8(o2[0], o2[1]); }
            }
        } else if (pn < 13 || pn >= 45) {
            bf16_t* dst = (pn < 13 ? ZS + (pn - 5) * 256 : pn < 53 ? SG1 + (pn - 45) * 256 : SG2 + (pn - 53) * 256) + 8 * cg; const bool sl = pn < 13;
#pragma unroll
            for (int ai = 0; ai < 2; ++ai)
#pragma unroll
                for (int m = 0; m < 4; ++m) { const int row = row0 + ai * HALF + m * 16;
#pragma unroll
                    for (int bj = 0; bj < 2; ++bj) { f32x4 v0 = acc[ai][bj][m][0], v1 = acc[ai][bj][m][1];
                        if (sl) { v0 = silu4(v0); v1 = silu4(v1); } else { v0 = sig4(v0); v1 = sig4(v1); }
                        *(u32x4*)(dst + (size_t)row * 2048 + bj * HALF) = pk8(v0, v1); } }
        } else {
            const int ch0 = 64 * (pn - 13) + 4 * cg;
#pragma unroll
            for (int ai = 0; ai < 2; ++ai)
#pragma unroll
                for (int m = 0; m < 4; ++m) { const int row = row0 + ai * HALF + m * 16;
                    const f32x4 uu = acc[ai][1][m][0] * acc[ai][0][m][0], tt = acc[ai][0][m][1] * silu4(acc[ai][1][m][1]);
                    typedef unsigned u32x2v __attribute__((ext_vector_type(2)));
                    u32x2v wu, wt; wu.x = cvt_pk_bf16(uu[0], uu[1]); wu.y = cvt_pk_bf16(uu[2], uu[3]); wt.x = cvt_pk_bf16(tt[0], tt[1]); wt.y = cvt_pk_bf16(tt[2], tt[3]);
                    *(u32x2v*)(U + (size_t)row * 2048 + ch0) = wu; *(u32x2v*)(T + (size_t)row * 2048 + ch0) = wt; }
        }
    }
};
struct EpiQ {
    static constexpr bool PERM = true, AFTER_DRAIN = false, HAS_MID = false;
    bf16_t *QN, *QR; const float* ssq; const float2* rope;
    __device__ __forceinline__ void operator()(const f32x4 (&acc)[2][2][4][2], const Unit& u, int wr, int wc, int fr, int fq) const {
        const int pn = u.pn, row0 = u.pm * BM + wr * 64 + fr, cg = wc * 4 + fq;
#pragma unroll
        for (int ai = 0; ai < 2; ++ai)
#pragma unroll
            for (int m = 0; m < 4; ++m) { const int row = row0 + ai * HALF + m * 16; const float rs = rsqrtf(ssq[row * 2] * (1.f / 512.f) + 1e-6f) * (0.07216878364870322f * 1.4426950408889634f);
                if (pn < 8) {
#pragma unroll
                    for (int bj = 0; bj < 2; ++bj) *(u32x4*)(QN + (size_t)row * 2048 + pn * 256 + bj * HALF + 8 * cg) = pk8(acc[ai][bj][m][0] * rs, acc[ai][bj][m][1] * rs);
                } else { const int head = 4 * (pn - 8) + wc; const f32x4* cs = (const f32x4*)(rope + (size_t)row * 32 + 8 * fq); f32x4 o1[2], o2[2];
#pragma unroll
                    for (int n = 0; n < 2; ++n) { const f32x4 x1 = acc[ai][0][m][n] * rs, x2 = acc[ai][1][m][n] * rs; const f32x4 c01 = cs[2 * n], c23 = cs[2 * n + 1];
                        o1[n] = (f32x4){x1[0] * c01[0] - x2[0] * c01[1], x1[1] * c01[2] - x2[1] * c01[3], x1[2] * c23[0] - x2[2] * c23[1], x1[3] * c23[2] - x2[3] * c23[3]};
                        o2[n] = (f32x4){x1[0] * c01[1] + x2[0] * c01[0], x1[1] * c01[3] + x2[1] * c01[2], x1[2] * c23[1] + x2[2] * c23[0], x1[3] * c23[3] + x2[3] * c23[2]}; }
                    *(u32x4*)(QR + (size_t)row * 1024 + 64 * head + 8 * fq) = pk8(o1[0], o1[1]); *(u32x4*)(QR + (size_t)row * 1024 + 64 * head + 32 + 8 * fq) = pk8(o2[0], o2[1]); }
            }
    }
};
struct EpiKV {
    static constexpr bool PERM = true, AFTER_DRAIN = false, HAS_MID = false;
    bf16_t *KN, *V; const float* ssq;
    __device__ __forceinline__ void operator()(const f32x4 (&acc)[2][2][4][2], const Unit& u, int wr, int wc, int fr, int fq) const {
        const int pn = u.pn, row0 = u.pm * BM + wr * 64 + fr, cg = wc * 4 + fq; bf16_t* dst = (pn < 8 ? KN + pn * 256 : V + (pn - 8) * 256) + 8 * cg;
#pragma unroll
        for (int ai = 0; ai < 2; ++ai)
#pragma unroll
            for (int m = 0; m < 4; ++m) { const int row = row0 + ai * HALF + m * 16; const float rs = rsqrtf(ssq[row * 2 + 1] * (1.f / 512.f) + 1e-6f);
#pragma unroll
                for (int bj = 0; bj < 2; ++bj) *(u32x4*)(dst + (size_t)row * 2048 + bj * HALF) = pk8(acc[ai][bj][m][0] * rs, acc[ai][bj][m][1] * rs); }
    }
};
__device__ __forceinline__ void unpk8(const u32x4& w, f32x4& a, f32x4& b) {
    a = (f32x4){__uint_as_float(w.x << 16), __uint_as_float(w.x & 0xffff0000u), __uint_as_float(w.y << 16), __uint_as_float(w.y & 0xffff0000u)};
    b = (f32x4){__uint_as_float(w.z << 16), __uint_as_float(w.z & 0xffff0000u), __uint_as_float(w.w << 16), __uint_as_float(w.w & 0xffff0000u)}; }
struct EpiMerge {
    static constexpr bool PERM = true, AFTER_DRAIN = false, HAS_MID = true;
    const bf16_t *sg1, *sg2; bf16_t* mg;
    __device__ __forceinline__ void mid(f32x4 (&acc)[2][2][4][2], const Unit& u, int wr, int wc, int fr, int fq) const {
        const size_t ub = (size_t)(u.pm * BM + wr * 64) * 2048 + u.pn * BM + 32 * wc; const unsigned lo = (unsigned)(fr * 2048 + 8 * fq);
#pragma unroll
        for (int ai = 0; ai < 2; ++ai)
#pragma unroll
            for (int m = 0; m < 4; ++m) { unsigned lo_ = lo; asm volatile("" : "+v"(lo_)); const size_t ro = ub + (size_t)(ai * HALF + m * 16) * 2048 + lo_;
#pragma unroll
                for (int bj = 0; bj < 2; ++bj) { f32x4 g0, g1, h0, h1; { const u32x4 q_ = *(const u32x4*)(sg1 + ro + bj * HALF); unpk8(q_, g0, g1); } { const u32x4 q_ = *(const u32x4*)(sg2 + ro + bj * HALF); unpk8(q_, h0, h1); }
#pragma unroll
                    for (int j = 0; j < 4; ++j) { acc[ai][bj][m][0][j] *= g0[j] * __builtin_amdgcn_rcpf(h0[j]); acc[ai][bj][m][1][j] *= g1[j] * __builtin_amdgcn_rcpf(h1[j]); } }
                asm volatile("" ::: "memory"); }
    }
    __device__ __forceinline__ void operator()(const f32x4 (&acc)[2][2][4][2], const Unit& u, int wr, int wc, int fr, int fq) const {
        const size_t ub = (size_t)(u.pm * BM + wr * 64) * 2048 + u.pn * BM + 32 * wc; const unsigned lo = (unsigned)(fr * 2048 + 8 * fq);
#pragma unroll
        for (int ai = 0; ai < 2; ++ai)
#pragma unroll
            for (int m = 0; m < 4; ++m) { unsigned lo_ = lo; asm volatile("" : "+v"(lo_)); const size_t ro = ub + (size_t)(ai * HALF + m * 16) * 2048 + lo_;
#pragma unroll
                for (int bj = 0; bj < 2; ++bj) { f32x4 h0, h1; { const u32x4 q_ = *(const u32x4*)(sg2 + ro + bj * HALF); unpk8(q_, h0, h1); }
                    *(u32x4*)(mg + ro + bj * HALF) = pk8(acc[ai][bj][m][0] * h0, acc[ai][bj][m][1] * h1); }
                asm volatile("" ::: "memory"); }
    }
};
struct EpiOut {
    static constexpr bool PERM = true, AFTER_DRAIN = false, HAS_MID = false;
    float* outf;
    __device__ __forceinline__ void operator()(const f32x4 (&acc)[2][2][4][2], const Unit& u, int wr, int wc, int fr, int fq) const {
        const int row0 = u.pm * BM + wr * 64 + fr, col0 = u.pn * BM + 8 * (wc * 4 + fq);
#pragma unroll
        for (int ai = 0; ai < 2; ++ai)
#pragma unroll
            for (int m = 0; m < 4; ++m) { const size_t ro = (size_t)(row0 + ai * HALF + m * 16) * 2048 + col0;
#pragma unroll
                for (int bj = 0; bj < 2; ++bj) { *(f32x4*)(outf + ro + bj * HALF) = acc[ai][bj][m][0]; *(f32x4*)(outf + ro + bj * HALF + 4) = acc[ai][bj][m][1]; } }
    }
};

template <class Epi, class Sched, bool ALIGN_EPI = false, bool SP2 = false>
__device__ __forceinline__ void gemm_phase(PG8_LAS unsigned char* lds, const Gemm g, const Sched& S, const Epi& E) {
    const int tid = threadIdx.x, wid = __builtin_amdgcn_readfirstlane(tid >> 6), lane = tid & 63, wr = wid >> 2, wc = wid & 3, fr = lane & 15, fq = lane >> 4;
    const int K = g.K, ns = K / BK, nt = g.A2 ? 2 * ns : ns;
    unsigned voffA[2], voffB[2];
#pragma unroll
    for (int i = 0; i < 2; ++i) { int R, C; stage_rc(tid * 16 + i * 8192, R, C); const int Rb = Epi::PERM ? ((R & ~31) + perm32(R & 31)) : R;
        voffA[i] = (unsigned)(R * K + C) * 2u; voffB[i] = (unsigned)(Rb * K + C) * 2u; }
    const size_t kstep = (size_t)(BK * 2);
    const size_t hstep = (size_t)HALF * K * 2;
    const size_t tstep = 2 * hstep;
    const unsigned ldsw = (unsigned)wid * 1024u;
    const int aoff = lds_byte(wr * 64 + fr, fq * 8), boff = lds_byte(wc * 32 + fr, fq * 8);
#define PG8_SA(b, h) (((b) * 2 + (h)) * HTB)
#define PG8_SB(b, h) ((4 + (b) * 2 + (h)) * HTB)
#define PG8_STAGE(bufoff, gbase, voff) do { _Pragma("unroll") for (int _i = 0; _i < 2; ++_i) \
        __builtin_amdgcn_global_load_lds((const unsigned*)((const char*)(gbase) + (voff)[_i]), (PG8_LAS unsigned*)(lds + (bufoff) + ldsw + _i * 8192), 16, 0, 0); } while (0)
#define PG8_LDA(dst, b, h) do { _Pragma("unroll") for (int m = 0; m < 4; ++m) _Pragma("unroll") for (int k = 0; k < 2; ++k) dst[m][k] = *(const PG8_LAS bf16x8*)(lds + PG8_SA(b, h) + aoff + m * 2048 + k * 1024); } while (0)
#define PG8_LDB(dst, b, h) do { _Pragma("unroll") for (int n = 0; n < 2; ++n) _Pragma("unroll") for (int k = 0; k < 2; ++k) dst[n][k] = *(const PG8_LAS bf16x8*)(lds + PG8_SB(b, h) + boff + n * 2048 + k * 1024); } while (0)
#define PG8_MMA(ai, bj, At, Bt) do { __builtin_amdgcn_s_setprio(1); _Pragma("unroll") for (int m = 0; m < 4; ++m) _Pragma("unroll") for (int n = 0; n < 2; ++n) _Pragma("unroll") for (int k = 0; k < 2; ++k) \
        acc[ai][bj][m][n] = __builtin_amdgcn_mfma_f32_16x16x32_bf16(Bt[n][k], At[m][k], acc[ai][bj][m][n], 0, 0, 0); __builtin_amdgcn_s_setprio(0); } while (0)
#define PG8_WAIT_V(n) asm volatile("s_waitcnt vmcnt(" #n ")" ::: "memory")
#define PG8_WAIT_L(n) asm volatile("s_waitcnt lgkmcnt(" #n ")" ::: "memory")
#define PG8_BAR __builtin_amdgcn_s_barrier()
#define PG8_SCHED __builtin_amdgcn_sched_barrier(0)
    Unit cur, nxt; int ui = 0;
    if (!S.next(0, cur)) return;
    f32x4 acc[2][2][4][2];
#pragma unroll
    for (int a = 0; a < 2; ++a)
#pragma unroll
        for (int b = 0; b < 2; ++b)
#pragma unroll
            for (int m = 0; m < 4; ++m)
#pragma unroll
                for (int n = 0; n < 2; ++n) acc[a][b][m][n] = (f32x4){0.f, 0.f, 0.f, 0.f};
    bf16x8 At[4][2], B0[2][2], B1[2][2];
    const char* cA = (const char*)g.A + (size_t)cur.pm * tstep; const char* cB = (const char*)g.Bt + (size_t)cur.pn * tstep;
    const long dA = g.A2 ? ((const char*)g.A2 - (const char*)g.A) - (long)ns * (long)kstep : 0, dB = g.A2 ? ((const char*)g.Bt2 - (const char*)g.Bt) - (long)ns * (long)kstep : 0;
    S.a_ready(cur);
    if constexpr (SP2) {
        PG8_STAGE(PG8_SB(0, 0), cB, voffB); PG8_STAGE(PG8_SB(0, 1), cB + hstep, voffB); PG8_STAGE(PG8_SA(0, 0), cA, voffA); PG8_STAGE(PG8_SA(0, 1), cA + hstep, voffA);
        if (wr == 1) PG8_BAR;
        PG8_WAIT_V(2); PG8_BAR;
        PG8_STAGE(PG8_SB(1, 0), cB + kstep, voffB); PG8_STAGE(PG8_SA(1, 0), cA + kstep, voffA); PG8_STAGE(PG8_SB(1, 1), cB + hstep + kstep, voffB);
        PG8_WAIT_V(6); PG8_BAR;
    } else {
        PG8_STAGE(PG8_SB(0, 0), cB, voffB); PG8_STAGE(PG8_SA(0, 0), cA, voffA); PG8_STAGE(PG8_SB(0, 1), cB + hstep, voffB); PG8_STAGE(PG8_SA(0, 1), cA + hstep, voffA);
        if (wr == 1) PG8_BAR;
        PG8_WAIT_V(4); PG8_BAR;
        PG8_STAGE(PG8_SB(1, 0), cB + kstep, voffB); PG8_STAGE(PG8_SA(1, 0), cA + kstep, voffA); PG8_STAGE(PG8_SB(1, 1), cB + hstep + kstep, voffB);
        PG8_WAIT_V(6); PG8_BAR;
    }
    for (;;) {
        const bool has_next = S.next(ui + 1, nxt);
        const char* nA = has_next ? (const char*)g.A + (size_t)nxt.pm * tstep : cA; const char* nB = has_next ? (const char*)g.Bt + (size_t)nxt.pn * tstep : cB;
        for (int t0 = 0; t0 < nt; t0 += ns) {
        if constexpr (Epi::HAS_MID) { if (t0 != 0) { PG8_SCHED; E.mid(acc, cur, wr, wc, fr, fq); PG8_SCHED; } }
        for (int t = t0; t < t0 + ns; t += 2) {
            const bool last = (t == nt - 2);
            const int t1 = t + 1, t2 = t + 2;
            const char* a1 = cA + (size_t)t1 * kstep + (t1 >= ns ? dA : 0);
            const char* a2 = last ? nA : cA + (size_t)t2 * kstep + (t2 >= ns ? dA : 0);
            const char* b2 = last ? nB : cB + (size_t)t2 * kstep + (t2 >= ns ? dB : 0);
            const char* a3 = a2 + kstep; const char* b3 = b2 + kstep;
            if (last && has_next) S.a_ready(nxt);
            if constexpr (SP2) {
            PG8_LDB(B0, 0, 0); PG8_LDB(B1, 0, 1); PG8_SCHED; PG8_LDA(At, 0, 0); PG8_STAGE(PG8_SA(1, 1), a1 + hstep, voffA);
            PG8_WAIT_V(8); PG8_WAIT_L(0); PG8_BAR; PG8_MMA(0, 0, At, B0); PG8_MMA(0, 1, At, B1); PG8_BAR; PG8_SCHED;
            PG8_LDA(At, 0, 1); PG8_STAGE(PG8_SB(0, 0), b2, voffB); PG8_STAGE(PG8_SB(0, 1), b2 + hstep, voffB); PG8_STAGE(PG8_SA(0, 0), a2, voffA);
            PG8_WAIT_V(8); PG8_WAIT_L(0); PG8_BAR; PG8_MMA(1, 0, At, B0); PG8_MMA(1, 1, At, B1); PG8_BAR; PG8_SCHED;
            PG8_LDB(B0, 1, 0); PG8_LDB(B1, 1, 1); PG8_SCHED; PG8_LDA(At, 1, 0); PG8_STAGE(PG8_SA(0, 1), a2 + hstep, voffA);
            PG8_WAIT_V(8); PG8_WAIT_L(0); PG8_BAR; PG8_MMA(0, 0, At, B0); PG8_MMA(0, 1, At, B1); PG8_BAR; PG8_SCHED;
            PG8_LDA(At, 1, 1); PG8_STAGE(PG8_SB(1, 0), b3, voffB); PG8_STAGE(PG8_SB(1, 1), b3 + hstep, voffB); PG8_STAGE(PG8_SA(1, 0), a3, voffA);
            PG8_WAIT_V(8); PG8_WAIT_L(0); PG8_BAR; PG8_MMA(1, 0, At, B0); PG8_MMA(1, 1, At, B1); PG8_BAR; PG8_SCHED;
            } else {
            PG8_LDB(B0, 0, 0); PG8_SCHED; PG8_LDA(At, 0, 0); PG8_STAGE(PG8_SA(1, 1), a1 + hstep, voffA);
            PG8_WAIT_L(8); PG8_BAR; PG8_WAIT_L(0); PG8_MMA(0, 0, At, B0); PG8_BAR; PG8_SCHED;
            PG8_LDB(B1, 0, 1); PG8_STAGE(PG8_SB(0, 0), b2, voffB);
            PG8_BAR; PG8_WAIT_L(0); PG8_MMA(0, 1, At, B1); PG8_BAR;
            PG8_LDA(At, 0, 1); PG8_STAGE(PG8_SA(0, 0), a2, voffA);
            PG8_BAR; PG8_WAIT_L(0); PG8_MMA(1, 0, At, B0); PG8_BAR; PG8_SCHED;
            PG8_STAGE(PG8_SB(0, 1), b2 + hstep, voffB);
            PG8_WAIT_V(6); PG8_BAR; PG8_MMA(1, 1, At, B1); PG8_BAR;
            PG8_LDB(B0, 1, 0); PG8_SCHED; PG8_LDA(At, 1, 0); PG8_STAGE(PG8_SA(0, 1), a2 + hstep, voffA);
            PG8_WAIT_L(8); PG8_BAR; PG8_WAIT_L(0); PG8_MMA(0, 0, At, B0); PG8_BAR; PG8_SCHED;
            PG8_LDB(B1, 1, 1); PG8_STAGE(PG8_SB(1, 0), b3, voffB);
            PG8_BAR; PG8_WAIT_L(0); PG8_MMA(0, 1, At, B1); PG8_BAR;
            PG8_LDA(At, 1, 1); PG8_STAGE(PG8_SA(1, 0), a3, voffA);
            PG8_BAR; PG8_WAIT_L(0); PG8_MMA(1, 0, At, B0); PG8_BAR; PG8_SCHED;
            PG8_STAGE(PG8_SB(1, 1), b3 + hstep, voffB);
            PG8_WAIT_V(6); PG8_BAR; PG8_MMA(1, 1, At, B1); PG8_BAR;
            }
        }
        }
        if constexpr (ALIGN_EPI) { if (wr == 0) PG8_BAR; }
        if constexpr (!Epi::AFTER_DRAIN) { E(acc, cur, wr, wc, fr, fq); S.done(cur); }
        if (!has_next) break;
#pragma unroll
        for (int a = 0; a < 2; ++a)
#pragma unroll
            for (int b = 0; b < 2; ++b)
#pragma unroll
                for (int m = 0; m < 4; ++m)
#pragma unroll
                    for (int n = 0; n < 2; ++n) acc[a][b][m][n] = (f32x4){0.f, 0.f, 0.f, 0.f};
        cur = nxt; cA = nA; cB = nB; ++ui;
        if constexpr (ALIGN_EPI) { if (wr == 1) PG8_BAR; }
    }
    PG8_WAIT_V(0);
    if constexpr (!ALIGN_EPI) { if (wr == 0) PG8_BAR; }
    PG8_BAR;
    if constexpr (Epi::AFTER_DRAIN) { E.fused(acc, cur, wr, wc, fr, fq, lds, wid, lane); S.done(cur); }
#undef PG8_SA
#undef PG8_SB
#undef PG8_STAGE
#undef PG8_LDA
#undef PG8_LDB
#undef PG8_MMA
#undef PG8_WAIT_V
#undef PG8_WAIT_L
#undef PG8_BAR
#undef PG8_SCHED
}
}

namespace att {
typedef short bf16x8 __attribute__((ext_vector_type(8)));
typedef short s16x4 __attribute__((ext_vector_type(4)));
typedef float f32x16 __attribute__((ext_vector_type(16)));
typedef float f32x4 __attribute__((ext_vector_type(4)));
typedef unsigned u32x4 __attribute__((ext_vector_type(4)));
constexpr int NW = 8, QBLK = 32, KVBLK = 64, QB = NW * QBLK, NQB = S / QB;
constexpr int SHM_V = KVBLK * 128 * 2, SHM_KN = KVBLK * 128 * 2, SHM_KR = KVBLK * 64 * 2;
constexpr int NVS = 3;
constexpr int OFF_V = 0, OFF_KN = NVS * SHM_V, OFF_KR = OFF_KN + 2 * SHM_KN, OFF_WS = OFF_KR + 2 * SHM_KR, OFF_QR = OFF_WS + NW * 64 * 4, LDS_BYTES = OFF_QR + NW * 4096;
constexpr float THR2 = 8.f * 1.4426950408889634f;
#define KSWZ(row, colB) ((row) * 256 + ((colB) ^ (((row) & 7) << 4)))
#define SBAR() __builtin_amdgcn_sched_barrier(0)
__device__ __forceinline__ int kr_off(int key, int ch8) { const int row = key & 31; return row * 256 + ((((key >> 5) * 8 + ch8) * 16) ^ ((row & 7) << 4)); }
__device__ __forceinline__ int v_st(int k, int c) { const int kk = (k & ~0xC) | ((k & 4) << 1) | ((k & 8) >> 1); return ((kk >> 3) * 4 + (c >> 5)) * 512 + ((kk & 7) * 32 + (c & 31)) * 2; }
__device__ __forceinline__ int v_rd_base(int lane) { return ((lane & 3) << 3) | (((lane >> 2) & 3) << 6) | (((lane >> 4) & 1) << 5) | (((lane >> 5) & 1) << 8); }
constexpr int v_rd_off(int d0, int ks, int half) { return d0 * 512 + ks * 4096 + half * 2048; }
__device__ __forceinline__ int crow(int r, int hi) { return (r & 3) + 8 * (r >> 2) + 4 * hi; }
__device__ __forceinline__ unsigned cvtpk(float lo, float hi) { unsigned r; asm volatile("v_cvt_pk_bf16_f32 %0, %1, %2" : "=v"(r) : "v"(lo), "v"(hi)); return r; }
__device__ __forceinline__ void mask_tile(f32x16& p0, f32x16& p1, int dq) {
    const float NEG = -__builtin_inff();
#pragma unroll
    for (int r = 0; r < 16; ++r) { const int c = (r & 3) + 8 * (r >> 2);
        if (dq - c < 0) p0[r] = NEG;
        if (dq - c - 32 < 0) p1[r] = NEG; }
}
__device__ __forceinline__ void partialSM(f32x16& p0, f32x16& p1, float& m_reg, float& mn, float& alpha) {
    float pmax = p0[0];
#pragma unroll
    for (int r = 1; r < 16; ++r) pmax = fmaxf(pmax, p0[r]);
#pragma unroll
    for (int r = 0; r < 16; ++r) pmax = fmaxf(pmax, p1[r]);
    { auto rr = __builtin_amdgcn_permlane32_swap(__float_as_uint(pmax), __float_as_uint(pmax), false, false);
      pmax = fmaxf(__uint_as_float(rr[0]), __uint_as_float(rr[1])); }
    if (__builtin_expect(__all((pmax - m_reg) <= THR2), 1)) { mn = m_reg; alpha = 1.f; }
    else { mn = fmaxf(m_reg, pmax); alpha = __builtin_amdgcn_exp2f(m_reg - mn); m_reg = mn; }
#pragma unroll
    for (int r = 0; r < 16; ++r) p0[r] = p0[r] - mn;
#pragma unroll
    for (int r = 0; r < 16; ++r) p1[r] = p1[r] - mn;
#pragma unroll
    for (int r = 0; r < 16; ++r) p0[r] = __builtin_amdgcn_exp2f(p0[r]);
}
__device__ __forceinline__ void finishSM(f32x16& p0, f32x16& p1, float alpha, float& l_reg, bf16x8& pa0, bf16x8& pa1, bf16x8& pa2, bf16x8& pa3) {
#pragma unroll
    for (int r = 0; r < 16; ++r) p1[r] = __builtin_amdgcn_exp2f(p1[r]);
    float ps = 0;
#pragma unroll
    for (int r = 0; r < 16; ++r) ps += p0[r];
#pragma unroll
    for (int r = 0; r < 16; ++r) ps += p1[r];
    { auto rr = __builtin_amdgcn_permlane32_swap(__float_as_uint(ps), __float_as_uint(ps), false, false);
      ps = __uint_as_float(rr[0]) + __uint_as_float(rr[1]); }
    l_reg = l_reg * alpha + ps;
#define PK4(P, B_, OUT) do { unsigned a0 = cvtpk(P[B_+0], P[B_+1]), a1 = cvtpk(P[B_+2], P[B_+3]);                          \
        unsigned b0 = cvtpk(P[B_+4], P[B_+5]), b1 = cvtpk(P[B_+6], P[B_+7]);                                             \
        auto r0 = __builtin_amdgcn_permlane32_swap(a0, b0, false, false); auto r1 = __builtin_amdgcn_permlane32_swap(a1, b1, false, false); \
        u32x4 w = {r0[0], r1[0], r0[1], r1[1]}; OUT = *reinterpret_cast<bf16x8*>(&w); } while (0)
    PK4(p0, 0, pa0); PK4(p0, 8, pa1); PK4(p1, 0, pa2); PK4(p1, 8, pa3);
#undef PK4
}
template <int KB>
__device__ __forceinline__ void qkt(f32x16& p0, f32x16& p1, const char* lds, int r32, int hi, const bf16x8* qr, const char* ql0, const char* ql1) {
    p0 = f32x16{}; p1 = f32x16{};
    const char* kb[4];
#pragma unroll
    for (int dd = 0; dd < 4; ++dd) kb[dd] = lds + OFF_KN + KB * SHM_KN + KSWZ(r32, (dd * 16 + hi * 8) * 2);
#pragma unroll
    for (int d0 = 0; d0 < 8; ++d0) { const char* a = kb[d0 & 3] + (d0 >> 2) * 128;
        bf16x8 b0 = *reinterpret_cast<const bf16x8*>(a);
        bf16x8 b1 = *reinterpret_cast<const bf16x8*>(a + 32 * 256);
        p0 = __builtin_amdgcn_mfma_f32_32x32x16_bf16(b0, qr[d0], p0, 0, 0, 0);
        p1 = __builtin_amdgcn_mfma_f32_32x32x16_bf16(b1, qr[d0], p1, 0, 0, 0); }
#pragma unroll
    for (int d0 = 0; d0 < 4; ++d0) { const char* a = kb[d0] + ((OFF_KR + KB * SHM_KR) - (OFF_KN + KB * SHM_KN));
        bf16x8 b0 = *reinterpret_cast<const bf16x8*>(a);
        bf16x8 b1 = *reinterpret_cast<const bf16x8*>(a + 128);
        const bf16x8 qf = *reinterpret_cast<const bf16x8*>(((d0 & 1) ? ql1 : ql0) + (d0 >> 1) * 2048);
        p0 = __builtin_amdgcn_mfma_f32_32x32x16_bf16(b0, qf, p0, 0, 0, 0);
        p1 = __builtin_amdgcn_mfma_f32_32x32x16_bf16(b1, qf, p1, 0, 0, 0); }
}
__device__ __forceinline__ void pv_tile(f32x16* o, int vb0, bf16x8 pa0, bf16x8 pa1, bf16x8 pa2, bf16x8 pa3) {
#define TRRD(dst, off) asm volatile("ds_read_b64_tr_b16 %0, %1 offset:%2" : "=&v"(dst) : "v"(vb0), "i"(off) : "memory")
#define PV_D0(d0) do { s16x4 l0, l1, l2, l3, h0, h1, h2, h3; constexpr int b_ = OFF_V + v_rd_off(d0, 0, 0);     \
        TRRD(l0, b_); TRRD(h0, b_ + 2048); TRRD(l1, b_ + 4096); TRRD(h1, b_ + 6144); TRRD(l2, b_ + 8192); TRRD(h2, b_ + 10240); TRRD(l3, b_ + 12288); TRRD(h3, b_ + 14336); \
        asm volatile("s_waitcnt lgkmcnt(0)" ::: "memory"); SBAR();   \
        o[d0] = __builtin_amdgcn_mfma_f32_32x32x16_bf16(pa0, (bf16x8){l0[0], l0[1], l0[2], l0[3], h0[0], h0[1], h0[2], h0[3]}, o[d0], 0, 0, 0);   \
        o[d0] = __builtin_amdgcn_mfma_f32_32x32x16_bf16(pa1, (bf16x8){l1[0], l1[1], l1[2], l1[3], h1[0], h1[1], h1[2], h1[3]}, o[d0], 0, 0, 0);   \
        o[d0] = __builtin_amdgcn_mfma_f32_32x32x16_bf16(pa2, (bf16x8){l2[0], l2[1], l2[2], l2[3], h2[0], h2[1], h2[2], h2[3]}, o[d0], 0, 0, 0);   \
        o[d0] = __builtin_amdgcn_mfma_f32_32x32x16_bf16(pa3, (bf16x8){l3[0], l3[1], l3[2], l3[3], h3[0], h3[1], h3[2], h3[3]}, o[d0], 0, 0, 0); } while (0)
    PV_D0(0); PV_D0(1); PV_D0(2); PV_D0(3);
#undef PV_D0
#undef TRRD
}
struct Tens { const bf16_t *QN, *QR, *KN, *KR, *V, *ZS; bf16_t* AO; };
struct BlockRef { int h, P0; };
struct Stage { bf16x8 st_v0, st_v1, st_k0, st_k1, st_kr; };
#define VMW() asm volatile("s_waitcnt vmcnt(0)" ::: "memory")
#define LD8(p) (*reinterpret_cast<const bf16x8*>(p))
#define SLOAD_ADV() do { asm volatile("" : "+s"(pV), "+s"(pK), "+s"(pR)); G.st_v0 = LD8(pV + lvo); G.st_v1 = LD8(pV + lvo2); G.st_k0 = LD8(pK + lvo); G.st_k1 = LD8(pK + lvo2); G.st_kr = LD8(pR + lro);   \
        pV += (size_t)KVBLK * 2048 * 2; pK += (size_t)KVBLK * 2048 * 2; pR += (size_t)KVBLK * 64 * 2; } while (0)
#define SWRITE_H(bf, vso) do { *(bf16x8*)(lds + OFF_V + (vso) + vst0) = G.st_v0; *(bf16x8*)(lds + OFF_V + (vso) + vst1) = G.st_v1;                          \
        *(bf16x8*)(lds + OFF_KN + (bf) * SHM_KN + kws) = G.st_k0; *(bf16x8*)(lds + OFF_KN + (bf) * SHM_KN + kws + 32 * 256) = G.st_k1; *(bf16x8*)(lds + OFF_KR + (bf) * SHM_KR + krws) = G.st_kr; } while (0)
__device__ __forceinline__ void softmax_tile(f32x16& p0, f32x16& p1, float& m_reg, float& l_reg, float& alpha, bf16x8& pa0, bf16x8& pa1, bf16x8& pa2, bf16x8& pa3) {
    float mn; partialSM(p0, p1, m_reg, mn, alpha);
    finishSM(p0, p1, alpha, l_reg, pa0, pa1, pa2, pa3);
}
__device__ __forceinline__ void attn_block(const Tens& T, const BlockRef& cur, char* lds) {
    const int tid = threadIdx.x, wid = __builtin_amdgcn_readfirstlane(tid >> 6), lane = tid & 63, r32 = lane & 31, hi = lane >> 5;
    const int NT = (cur.P0 + QB) / KVBLK;
    const int qlo = cur.P0 + wid * QBLK, qm = qlo + r32 - 4 * hi;
    float* ws = (float*)(lds + OFF_WS) + wid * 64; float* li_l = ws, * al_l = ws + 32;
    float m_reg = -1e30f, l_reg = 0; f32x16 o[4] = {};
    const int sr = tid >> 4, sc = (tid & 15) * 8, vst0 = v_st(sr, sc), vst1 = v_st(32 + sr, sc), kws = KSWZ(sr, sc * 2), krow = tid >> 3, kch = tid & 7, krws = kr_off(krow, kch);
    const int vb0 = (int)(uintptr_t)(lds) + v_rd_base(lane);
    const int hh = cur.h;
    Stage G; bf16x8 qr[8];
    char* const ql0 = lds + OFF_QR + wid * 4096 + r32 * 64 + (((hi) ^ ((r32 >> 2) & 3)) << 4); char* const ql1 = lds + OFF_QR + wid * 4096 + r32 * 64 + (((2 + hi) ^ ((r32 >> 2) & 3)) << 4);
    const unsigned lvo = (unsigned)(sr * 2048 + sc) * 2u, lvo2 = lvo + 32u * 2048u * 2u, lro = (unsigned)(krow * 64 + kch * 8) * 2u;
    const char* pV = (const char*)(T.V + hh * 128); const char* pK = (const char*)(T.KN + hh * 128); const char* pR = (const char*)T.KR;
    SLOAD_ADV();
    { const size_t qrow_ = (size_t)(cur.P0 + wid * QBLK + r32);
#pragma unroll
      for (int d0 = 0; d0 < 8; ++d0) qr[d0] = LD8(T.QN + qrow_ * 2048 + hh * 128 + d0 * 16 + hi * 8);
      const bf16_t* qp_ = T.QR + qrow_ * 1024 + hh * 64 + hi * 8;
      const bf16x8 t0 = LD8(qp_), t1 = LD8(qp_ + 16), t2 = LD8(qp_ + 32), t3 = LD8(qp_ + 48);
      *(bf16x8*)(ql0) = t0; *(bf16x8*)(ql1) = t1; *(bf16x8*)(ql0 + 2048) = t2; *(bf16x8*)(ql1 + 2048) = t3; }
    VMW(); SWRITE_H(0, 0);
    SLOAD_ADV();
    f32x16 p0, p1; float alpha; bf16x8 pa0, pa1, pa2, pa3;
    const bool hb = wid >= 4;
    int so_prev = 2 * SHM_V, so_cur = 0, so_next = SHM_V;
#define ROT() do { const int t_ = so_prev; so_prev = so_cur; so_cur = so_next; so_next = t_; } while (0)
#define STAGE_T(t, BF) do { __syncthreads(); if ((t) + 1 < NT) { VMW(); SWRITE_H((BF) ^ 1, so_next); } if ((t) + 2 < NT) { SLOAD_ADV(); } } while (0)
#define QK_SM(t, BF) do { SBAR(); qkt<BF>(p0, p1, lds, r32, hi, qr, ql0, ql1);                                               \
        { const int kb_ = (t) * KVBLK; if (kb_ + KVBLK - 1 > qlo) mask_tile(p0, p1, qm - kb_); }                              \
        softmax_tile(p0, p1, m_reg, l_reg, alpha, pa0, pa1, pa2, pa3);                                                        \
        if (__any(alpha < 1.f)) { if (hi == 0) al_l[r32] = alpha; asm volatile("s_waitcnt lgkmcnt(0)" ::: "memory");          \
            _Pragma("unroll") for (int d_ = 0; d_ < 4; ++d_) _Pragma("unroll") for (int r = 0; r < 16; ++r) o[d_][r] *= al_l[crow(r, hi)]; } } while (0)
#define PV_T(so) do { SBAR(); pv_tile(o, vb0 + (so), pa0, pa1, pa2, pa3); } while (0)
    if (!hb) {
        for (int t = 0; t < NT; t += 2) {
            STAGE_T(t, 0); QK_SM(t, 0); PV_T(so_cur); ROT();
            STAGE_T(t + 1, 1); QK_SM(t + 1, 1); PV_T(so_cur); ROT(); }
    } else {
        STAGE_T(0, 0); QK_SM(0, 0); ROT();
        for (int t = 1; t + 1 < NT; t += 2) {
            STAGE_T(t, 1); PV_T(so_prev); QK_SM(t, 1); ROT();
            STAGE_T(t + 1, 0); PV_T(so_prev); QK_SM(t + 1, 0); ROT(); }
        STAGE_T(NT - 1, 1); PV_T(so_prev); QK_SM(NT - 1, 1); ROT();
        PV_T(so_prev);
    }
#undef ROT
#undef STAGE_T
#undef QK_SM
#undef PV_T
    if (hi == 0) li_l[r32] = l_reg; asm volatile("s_waitcnt lgkmcnt(0)" ::: "memory");
    float rli[16];
#pragma unroll
    for (int r = 0; r < 16; ++r) rli[r] = __builtin_amdgcn_rcpf(li_l[crow(r, hi)]);
    const size_t ob = (size_t)(cur.P0 + wid * QBLK) * 2048 + hh * 128;
#pragma unroll
    for (int r = 0; r < 16; ++r) { unsigned lo_ = (unsigned)(4 * hi * 2048 + r32); asm volatile("" : "+v"(lo_));
        const size_t rb = ob + (size_t)((r & 3) + 8 * (r >> 2)) * 2048 + lo_;
#pragma unroll
        for (int d0 = 0; d0 < 4; ++d0) { const size_t idx = rb + d0 * 32;
            const float v = o[d0][r] * rli[r] * bf2f(T.ZS[idx]);
            const float vn = __shfl_xor(v, 1);
            if ((r32 & 1) == 0) *(unsigned*)(T.AO + idx) = cvtpk(v, vn); } }
    __syncthreads();
}
__device__ __forceinline__ BlockRef item_ref(int L, int pass) { const int xc = L & 7, k = L >> 3; BlockRef r; r.h = 2 * xc + (k >> 4); const int x = k & 15; r.P0 = (pass ? 31 - x : x) * QB; return r; }
__device__ __forceinline__ void attn_phase(const Tens& T, char* lds) {
    for (int L = blockIdx.x; L < NH * 16; L += gridDim.x)
        for (int pass = 0; pass < 2; ++pass) attn_block(T, item_ref(L, pass), lds);
}
#undef VMW
#undef LD8
#undef SLOAD_ADV
#undef SWRITE_H
#undef KSWZ
#undef SBAR
}

#define XB_TMO      128
#define XB_XCNT(j)  (256  + 64 * (j))
#define XB_XSUB(j)  (1280 + 64 * (j))
#define XB_XGEN(j)  (2304 + 64 * (j))
#define XB_TOP      3328
#define XB_TOPGEN   3392
#define XCD_BAR_WORDS 3456
#define XB_SPIN_CAP (1u << 18)

__device__ __forceinline__ unsigned xb_ld(unsigned* p)              { return __hip_atomic_load(p, __ATOMIC_RELAXED, __HIP_MEMORY_SCOPE_AGENT); }
__device__ __forceinline__ unsigned xb_add(unsigned* p, unsigned v) { return __hip_atomic_fetch_add(p, v, __ATOMIC_RELAXED, __HIP_MEMORY_SCOPE_AGENT); }
__device__ __forceinline__ unsigned xb_xcc_id() { return (unsigned)__builtin_amdgcn_s_getreg((3 << 11) | 20) & 0xFu; }
#define XB_SPIN(cond, bar) do { unsigned _sp = 0; while (cond) { __builtin_amdgcn_s_sleep(1); \
    if ((++_sp & 255u) == 0u) { if (xb_ld(&(bar)[XB_TMO])) break; if (_sp > XB_SPIN_CAP) { atomicAdd(&(bar)[XB_TMO], 1u); break; } } } } while (0)

struct XcdBarrier {
    unsigned* bar; unsigned x;
    volatile LAS unsigned* st;
};

__device__ __forceinline__ XcdBarrier xcd_barrier_post(unsigned* bar, volatile LAS unsigned* st) {
    XcdBarrier b; b.bar = bar; b.x = xb_xcc_id(); b.st = st;
    if (threadIdx.x == 0) (void)xb_add(&bar[XB_XCNT(b.x)], 1u);
    return b;
}
__device__ __forceinline__ void xcd_barrier_complete(unsigned* bar, unsigned x, unsigned& nloc, unsigned& nx) {
    const unsigned G = gridDim.x * gridDim.y * gridDim.z;
    unsigned sum, cnt, mine, sp = 0u;
    for (;;) {
        sum = 0u; cnt = 0u; mine = 0u;
#pragma unroll
        for (unsigned j = 0; j < 16; ++j) { const unsigned c = xb_ld(&bar[XB_XCNT(j)]); sum += c; cnt += (c > 0u) ? 1u : 0u; mine = (j == x) ? c : mine; }
        if (sum == G) break;
        __builtin_amdgcn_s_sleep(1);
        if ((++sp & 255u) == 0u) { if (xb_ld(&bar[XB_TMO])) break; if (sp > XB_SPIN_CAP) { atomicAdd(&bar[XB_TMO], 1u); break; } }
    }
    nloc = mine > 0u ? mine : 1u; nx = cnt > 0u ? cnt : 1u;
}

__device__ __forceinline__ void xcd_barrier(const XcdBarrier& b) {
    asm volatile("s_waitcnt vmcnt(0)" ::: "memory");
    __syncthreads();
    if (threadIdx.x == 0) {
        unsigned* bar = b.bar;
        __builtin_amdgcn_s_waitcnt(0);
        unsigned nloc = b.st[0], nx = b.st[1];
        if (nloc == 0u) { xcd_barrier_complete(bar, b.x, nloc, nx); b.st[0] = nloc; b.st[1] = nx; }
        const unsigned old = xb_add(&bar[XB_XSUB(b.x)], 1u);
        const unsigned gen = old / nloc;
        if (old + 1u == (gen + 1u) * nloc) {
            __builtin_amdgcn_fence(__ATOMIC_RELEASE, "agent");
            asm volatile("s_waitcnt vmcnt(0)" ::: "memory");
            const unsigned og = xb_add(&bar[XB_TOP], 1u);
            const unsigned tg = og / nx;
            if (og + 1u == (tg + 1u) * nx) xb_add(&bar[XB_TOPGEN], 1u);
            else XB_SPIN(xb_ld(&bar[XB_TOPGEN]) == tg, bar);
            __builtin_amdgcn_fence(__ATOMIC_ACQUIRE, "agent");
            xb_add(&bar[XB_XGEN(b.x)], 1u);
            asm volatile("s_waitcnt vmcnt(0)" ::: "memory");
        } else {
            XB_SPIN(xb_ld(&bar[XB_XGEN(b.x)]) == gen, bar);
            __builtin_amdgcn_fence(__ATOMIC_ACQUIRE, "agent");
            asm volatile("s_waitcnt vmcnt(0)" ::: "memory");
        }
    }
    __syncthreads();
}

constexpr int NWAVES = 8;
constexpr int RING_OFF = 0, RING_BYTES = 139264;
constexpr int LDSCTL_OFF = RING_BYTES, MISC_OFF = LDSCTL_OFF + 320;
constexpr int LDS_BYTES = 147456;
constexpr int CW_TMO = 0, CW_CODE = 1, CW_BAR = 4096;
constexpr int NPHASE = 7;
#ifndef MK_N_LAUNCHES
#define MK_N_LAUNCHES 1
#endif

typedef float f32x4 __attribute__((ext_vector_type(4)));
#define LDS_WAIT() asm volatile("s_waitcnt lgkmcnt(0)" ::: "memory")
#define VM_WAIT() asm volatile("s_waitcnt vmcnt(0)" ::: "memory")

struct Args { const float* in[13]; float* out; unsigned char* ws; int ph_lo, ph_hi, li, pad; };
struct TrItem { const float* W; const float* gain; bf16_t* WT; int N, K, k0, n0, sc; };
constexpr int TI_IN = (DM / 64) * (N1P / 256), TI_Q = (QL / 64) * (NQ / 256), TI_KV = (KVL / 64) * (NKV / 256), TI_O = (DM / 64) * (DM / 256);
constexpr int TI_SMALL = TI_Q + TI_KV + 3 * TI_O;
__device__ __forceinline__ TrItem tr_decode(const Args& A, int it, int tid) {
    TrItem r; int i = it; const int np = tid & 255; int nblk, mp;
    if (i < TI_IN) { r.W = A.in[3]; r.gain = nullptr; r.WT = (bf16_t*)(A.ws + WS_WINT); r.N = IN_TOTAL; r.K = DM; nblk = N1P / 256; mp = 1; }
    else { i -= TI_IN;
        if (i < TI_Q) { r.W = A.in[5]; r.gain = A.in[4]; r.WT = (bf16_t*)(A.ws + WS_WQT); r.N = NQ; r.K = QL; nblk = NQ / 256; mp = 2; }
        else { i -= TI_Q;
            if (i < TI_KV) { r.W = A.in[7]; r.gain = A.in[6]; r.WT = (bf16_t*)(A.ws + WS_WKVT); r.N = NKV; r.K = KVL; nblk = NKV / 256; mp = 3; }
            else { i -= TI_KV; const int w = i / TI_O; i -= w * TI_O; r.W = w == 0 ? A.in[9] : w == 1 ? A.in[10] : A.in[11]; r.WT = (bf16_t*)(A.ws + (w == 0 ? WS_WOMT : w == 1 ? WS_WOCT : WS_WOUTT)); r.gain = nullptr; r.N = DM; r.K = DM; nblk = DM / 256; mp = 0; } } }
    const int kb = i / nblk, nb = i - kb * nblk; r.k0 = 64 * kb; r.n0 = 256 * nb;
    r.sc = mp == 1 ? srcmap<1>(r.n0 + np) : mp == 2 ? srcmap<2>(r.n0 + np) : mp == 3 ? srcmap<3>(r.n0 + np) : r.n0 + np;
    return r;
}
__device__ __forceinline__ void tr_load(const TrItem& r, int tid, float (&v)[32]) {
    const int kh = (tid >> 8) * 32;
    if (r.sc >= 0) {
        const GAS float* src = (const GAS float*)r.W + (size_t)(r.k0 + kh) * r.N + r.sc;
#pragma unroll
        for (int i = 0; i < 32; ++i) v[i] = src[(size_t)i * r.N];
    } else {
#pragma unroll
        for (int i = 0; i < 32; ++i) v[i] = 0.f;
    }
}
__device__ __forceinline__ void tr_stream(const Args& T, LAS unsigned char* scr, int first, int stride, int end, int tid) {
    if (first >= end) return;
    float v[32]; int it = first, buf = 0;
    TrItem cur = tr_decode(T, it, tid); tr_load(cur, tid, v);
    for (;;) {
        const int np = tid & 255, kh = (tid >> 8) * 32;
        if (cur.gain) {
#pragma unroll
            for (int i = 0; i < 32; ++i) v[i] *= cur.gain[cur.k0 + kh + i];
        }
        LAS unsigned* row = (LAS unsigned*)(scr + buf * 34816 + np * 136 + kh * 2);
#pragma unroll
        for (int i = 0; i < 16; ++i) row[i] = pk2(v[2 * i], v[2 * i + 1]);
        const int nx = it + stride; const bool more = nx < end;
        TrItem nxt = cur;
        if (more) { nxt = tr_decode(T, nx, tid); tr_load(nxt, tid, v); }
        __syncthreads();
#pragma unroll
        for (int p = 0; p < 4; ++p) { const int r = (tid >> 3) + 64 * p, c = tid & 7;
            const LAS unsigned long long* q = (const LAS unsigned long long*)(scr + buf * 34816 + r * 136 + c * 16);
            const unsigned long long lo = q[0], hi = q[1];
            v4u o; o.x = (unsigned)lo; o.y = (unsigned)(lo >> 32); o.z = (unsigned)hi; o.w = (unsigned)(hi >> 32);
            *(GAS v4u*)(cur.WT + (size_t)(cur.n0 + r) * cur.K + cur.k0 + 8 * c) = o; }
        if (!more) break;
        cur = nxt; it = nx; buf ^= 1;
    }
    __syncthreads();
}

__global__ void __launch_bounds__(NWAVES * 64, 2) mk_fwd(Args args) {
    extern __shared__ __attribute__((aligned(16))) unsigned char lds[];
    LAS unsigned char* ldsp = (LAS unsigned char*)lds;
    volatile LAS unsigned* MISC = (volatile LAS unsigned*)(ldsp + MISC_OFF);
    const int tid = threadIdx.x, lane = tid & 63, wave = __builtin_amdgcn_readfirstlane(tid >> 6);
    const int G = gridDim.x; const int vcu = (G % 8 == 0) ? ((int)blockIdx.x % 8) * (G / 8) + (int)blockIdx.x / 8 : (int)blockIdx.x;
#define P_ws (args.ws)
#define P_ctl ((unsigned*)(P_ws + WS_CTL))
#define P_x (args.in[0])
#define P_pos ((const int*)args.in[1])
#define P_g_pre (args.in[2])
#define P_conv_w (args.in[8])
#define P_g_post (args.in[12])
#define P_ssq ((float*)(P_ws + WS_SSQ))
#define P_rope ((float2*)(P_ws + WS_ROPE))
#define P_WQT ((bf16_t*)(P_ws + WS_WQT))
#define P_WKVT ((bf16_t*)(P_ws + WS_WKVT))
#define P_WOMT ((bf16_t*)(P_ws + WS_WOMT))
#define P_WOCT ((bf16_t*)(P_ws + WS_WOCT))
#define P_WOUTT ((bf16_t*)(P_ws + WS_WOUTT))
#define P_WINT ((bf16_t*)(P_ws + WS_WINT))
#define P_H ((bf16_t*)(P_ws + WS_H))
#define P_AO ((bf16_t*)(P_ws + WS_AO))
#define P_QA ((bf16_t*)(P_ws + WS_QA))
#define P_CKV ((bf16_t*)(P_ws + WS_CKV))
#define P_KR ((bf16_t*)(P_ws + WS_KR))
#define P_ZS ((bf16_t*)(P_ws + WS_ZS))
#define P_U ((bf16_t*)(P_ws + WS_U))
#define P_T ((bf16_t*)(P_ws + WS_T))
#define P_SG1 ((bf16_t*)(P_ws + WS_SG1))
#define P_SG2 ((bf16_t*)(P_ws + WS_SG2))
#define P_QN ((bf16_t*)(P_ws + WS_QN))
#define P_QR ((bf16_t*)(P_ws + WS_QR))
#define P_KN ((bf16_t*)(P_ws + WS_KN))
#define P_V ((bf16_t*)(P_ws + WS_V))
#define P_AC ((bf16_t*)(P_ws + WS_AC))
#define P_MG ((bf16_t*)(P_ws + WS_MG))
#define P_OUTF ((float*)(P_ws + WS_OUTF))

    for (int u = tid; u < (LDS_BYTES - LDSCTL_OFF) / 4; u += NWAVES * 64) ((LAS unsigned*)(ldsp + LDSCTL_OFF))[u] = 0u;
    __syncthreads();
    const int lo = args.ph_lo, hi = args.ph_hi;
    const bool use_bar = (hi - lo) > 1;
    XcdBarrier bar; bar.bar = P_ctl + CW_BAR + args.li * XCD_BAR_WORDS; bar.x = 0; bar.st = nullptr;
    if (use_bar) bar = xcd_barrier_post(P_ctl + CW_BAR + args.li * XCD_BAR_WORDS, MISC + 8);
#ifndef PH_EN
#define PH_EN 0x7F
#endif
#ifndef PROBE_DUP
#define PROBE_DUP -1
#endif
#define REPS(k) for (int rep_ = 0; rep_ < ((PROBE_DUP == (k)) ? 2 : 1); ++rep_)
#define REPBAR(k) do { if (PROBE_DUP == (k) && rep_ == 0) xcd_barrier(bar); } while (0)
#define IN(k) (((PH_EN >> (k)) & 1) && lo <= (k) && (k) < hi)
#define SEAM(k) do { if (lo <= (k) && (k) + 1 < hi) xcd_barrier(bar); } while (0)
    const int gw = vcu * NWAVES + wave, NGW = G * NWAVES;

    if (IN(0)) REPS(0) {
        for (int i = (int)blockIdx.x * (NWAVES * 64) + tid; i < S * 32; i += G * NWAVES * 64) {
            const int s = i >> 5, j = i & 31;
            const float inv = exp2f(-(float)(2 * j) / 64.f * 13.287712379549449f);
            const float ang = (float)P_pos[s] * inv;
            const double a = (double)ang, kq = rint(a * 0.15915494309189535), r = a - kq * 6.283185307179586;
            const float rf = (float)r;
            P_rope[i] = make_float2(cosf(rf), sinf(rf));
        }
        for (int m = gw; m < S; m += NGW) {
            const GAS f32x4* xr = (const GAS f32x4*)(P_x + (size_t)m * DM) + lane;
            f32x4 v[8]; float s = 0.f;
#pragma unroll
            for (int j = 0; j < 8; ++j) { v[j] = xr[64 * j]; s += (v[j].x * v[j].x + v[j].y * v[j].y) + (v[j].z * v[j].z + v[j].w * v[j].w); }
            const float r = rsqrtf(wave_sum(s) * (1.f / DM) + RMS_EPS);
            GAS unsigned long long* o8 = (GAS unsigned long long*)(P_H + (size_t)m * DM) + lane;
#pragma unroll
            for (int j = 0; j < 8; ++j) { const f32x4 gg = ((const GAS f32x4*)P_g_pre)[lane + 64 * j];
                o8[64 * j] = (unsigned long long)pk2(v[j].x * r * gg.x, v[j].y * r * gg.y) | ((unsigned long long)pk2(v[j].z * r * gg.z, v[j].w * r * gg.w) << 32); }
        }
        tr_stream(args, ldsp + RING_OFF, vcu, G, TI_IN, tid);
        REPBAR(0);
    }
    SEAM(0);
    if (IN(1)) REPS(1) {
        pg8::Gemm g{P_H, P_WINT, S, N1P, DM}; pg8::StaticOrder So; So.init(S, N1P, G, (int)blockIdx.x);
        pg8::EpiP1 E{P_QA, P_CKV, P_KR, P_ZS, P_U, P_T, P_SG1, P_SG2, P_ssq, P_rope};
        pg8::gemm_phase<pg8::EpiP1, pg8::StaticOrder, true, true>(ldsp + RING_OFF, g, So, E);
        { const int nwg = (S / 256) * (N1P / 256), rem = nwg % G;
          const int first = rem == 0 ? (int)blockIdx.x : (int)blockIdx.x >= rem ? (int)blockIdx.x - rem : TI_SMALL, stride = rem == 0 ? G : G - rem;
          tr_stream(args, ldsp + RING_OFF, TI_IN + first, stride, TI_IN + TI_SMALL, tid); }
        REPBAR(1);
    }
    SEAM(1);
    if (IN(2)) REPS(2) {
        { pg8::Gemm g{P_QA, P_WQT, S, NQ, QL}; pg8::StaticOrder So; So.init(S, NQ, G, (int)blockIdx.x);
          pg8::EpiQ E{P_QN, P_QR, P_ssq, P_rope};
          pg8::gemm_phase<pg8::EpiQ, pg8::StaticOrder, true, true>(ldsp + RING_OFF, g, So, E); }
        { pg8::Gemm g{P_CKV, P_WKVT, S, NKV, KVL}; pg8::StaticOrder So; So.init(S, NKV, G, (int)blockIdx.x);
          pg8::EpiKV E{P_KN, P_V, P_ssq};
          pg8::gemm_phase<pg8::EpiKV, pg8::StaticOrder, true, true>(ldsp + RING_OFF, g, So, E); }
        for (size_t i = (size_t)blockIdx.x * (NWAVES * 64) + tid; i < (size_t)S * DM / 8; i += (size_t)G * NWAVES * 64) {
            const int s = (int)(i >> 8), c8 = (int)(i & 255) * 8; const size_t e = (size_t)s * DM + c8;
            f32x4 a0, a1, b0, b1, c0, c1, t0, t1;
            { const v4u q_ = *(const GAS v4u*)(P_U + e); pg8::unpk8(q_, a0, a1); }
            if (s >= 1) { const v4u q_ = *(const GAS v4u*)(P_U + e - DM); pg8::unpk8(q_, b0, b1); } else { b0 = (f32x4){0.f, 0.f, 0.f, 0.f}; b1 = b0; }
            if (s >= 2) { const v4u q_ = *(const GAS v4u*)(P_U + e - 2 * DM); pg8::unpk8(q_, c0, c1); } else { c0 = (f32x4){0.f, 0.f, 0.f, 0.f}; c1 = c0; }
            { const v4u q_ = *(const GAS v4u*)(P_T + e); pg8::unpk8(q_, t0, t1); }
            const f32x4 w00 = *(const GAS f32x4*)(P_conv_w + c8), w01 = *(const GAS f32x4*)(P_conv_w + c8 + 4);
            const f32x4 w10 = *(const GAS f32x4*)(P_conv_w + DM + c8), w11 = *(const GAS f32x4*)(P_conv_w + DM + c8 + 4);
            const f32x4 w20 = *(const GAS f32x4*)(P_conv_w + 2 * DM + c8), w21 = *(const GAS f32x4*)(P_conv_w + 2 * DM + c8 + 4);
            const f32x4 r0 = t0 * (w00 * c0 + w10 * b0 + w20 * a0), r1 = t1 * (w01 * c1 + w11 * b1 + w21 * a1);
            v4u o; o.x = pk2(r0[0], r0[1]); o.y = pk2(r0[2], r0[3]); o.z = pk2(r1[0], r1[1]); o.w = pk2(r1[2], r1[3]);
            *(GAS v4u*)(P_AC + e) = o;
        }
        REPBAR(2);
    }
    SEAM(2);
    if (IN(3)) REPS(3) {
        att::Tens AT{P_QN, P_QR, P_KN, P_KR, P_V, P_ZS, P_AO};
        static_assert(att::LDS_BYTES <= RING_BYTES, "attention LDS");
        att::attn_phase(AT, (char*)lds + RING_OFF);
        REPBAR(3);
    }
    SEAM(3);
    if (IN(4)) REPS(4) {
        pg8::Gemm g{P_AO, P_WOMT, S, DM, DM, P_AC, P_WOCT}; pg8::StaticOrder So; So.init(S, DM, G, (int)blockIdx.x);
        pg8::EpiMerge E{P_SG1, P_SG2, P_MG};
        pg8::gemm_phase<pg8::EpiMerge, pg8::StaticOrder, true, true>(ldsp + RING_OFF, g, So, E);
        REPBAR(4);
    }
    SEAM(4);
    if (IN(5)) REPS(5) {
        pg8::Gemm g{P_MG, P_WOUTT, S, DM, DM}; pg8::StaticOrder So; So.init(S, DM, G, (int)blockIdx.x);
        pg8::EpiOut E{P_OUTF};
        pg8::gemm_phase<pg8::EpiOut, pg8::StaticOrder, true, true>(ldsp + RING_OFF, g, So, E);
        REPBAR(5);
    }
    SEAM(5);
    if (IN(6)) REPS(6) {
        for (int m = gw; m < S; m += NGW) {
            const GAS f32x4* yr = (const GAS f32x4*)(P_OUTF + (size_t)m * DM) + lane; const GAS f32x4* xr = (const GAS f32x4*)(P_x + (size_t)m * DM) + lane;
            f32x4 v[8]; float s = 0.f;
#pragma unroll
            for (int j = 0; j < 8; ++j) { v[j] = yr[64 * j]; s += (v[j].x * v[j].x + v[j].y * v[j].y) + (v[j].z * v[j].z + v[j].w * v[j].w); }
            const float r = rsqrtf(wave_sum(s) * (1.f / DM) + RMS_EPS);
            GAS f32x4* orow = (GAS f32x4*)(args.out + (size_t)m * DM) + lane;
#pragma unroll
            for (int j = 0; j < 8; ++j) { const f32x4 gg = ((const GAS f32x4*)P_g_post)[lane + 64 * j]; orow[64 * j] = xr[64 * j] + v[j] * r * gg; }
        }
        REPBAR(6);
    }
#undef IN
#undef SEAM
#undef P_ws
#undef P_ctl
#undef P_x
#undef P_pos
#undef P_g_pre
#undef P_conv_w
#undef P_g_post
#undef P_ssq
#undef P_rope
#undef P_WQT
#undef P_WKVT
#undef P_WOMT
#undef P_WOCT
#undef P_WOUTT
#undef P_WINT
#undef P_H
#undef P_AO
#undef P_QA
#undef P_CKV
#undef P_KR
#undef P_ZS
#undef P_U
#undef P_T
#undef P_SG1
#undef P_SG2
#undef P_QN
#undef P_QR
#undef P_KN
#undef P_V
#undef P_AC
#undef P_MG
#undef P_OUTF
}

__global__ void __launch_bounds__(256) k_prep_misc(const int* pos, float2* rope, float* ssq) {
    const int i = blockIdx.x * 256 + threadIdx.x;
    if (i < S * 32) {
        const int s = i >> 5, j = i & 31;
        const float inv = exp2f(-(float)(2 * j) / 64.f * 13.287712379549449f);
        const float ang = (float)pos[s] * inv;
        const double a = (double)ang;
        const double k = rint(a * 0.15915494309189535);
        const double r = a - k * 6.283185307179586;
        const float rf = (float)r;
        rope[i] = make_float2(cosf(rf), sinf(rf));
    }
    if (i < S * 2) ssq[i] = 0.f;
}
__global__ void __launch_bounds__(256) k_xnorm(const float* x, const float* g, bf16_t* H) {
    const int row = blockIdx.x * 4 + (threadIdx.x >> 6), lane = threadIdx.x & 63;
    const float4* xr = (const float4*)(x + (size_t)row * DM);
    float4 v[8]; float s = 0.f;
#pragma unroll
    for (int j = 0; j < 8; ++j) { v[j] = xr[lane + 64 * j]; s += v[j].x * v[j].x + v[j].y * v[j].y + v[j].z * v[j].z + v[j].w * v[j].w; }
    const float r = rsqrtf(wave_sum(s) * (1.f / DM) + RMS_EPS);
#pragma unroll
    for (int j = 0; j < 8; ++j) {
        const float4 gg = ((const float4*)g)[lane + 64 * j];
        ushort4 o; o.x = f2bf(v[j].x * r * gg.x); o.y = f2bf(v[j].y * r * gg.y); o.z = f2bf(v[j].z * r * gg.z); o.w = f2bf(v[j].w * r * gg.w);
        ((ushort4*)(H + (size_t)row * DM))[lane + 64 * j] = o;
    }
}

template <int ND, class F>
__global__ void __launch_bounds__(256) nv_dots(F f) {
    const int c = blockIdx.x * 256 + threadIdx.x, r0 = blockIdx.y * 8;
    const bool act = c < f.ncols; const int cc = act ? c : 0;
    float acc[ND][8];
#pragma unroll
    for (int d = 0; d < ND; ++d)
#pragma unroll
        for (int i = 0; i < 8; ++i) acc[d][i] = 0.f;
    int wc[ND];
#pragma unroll
    for (int d = 0; d < ND; ++d) wc[d] = f.wcol(d, cc);
    for (int k = 0; k < f.K; k += 8) {
        float a[8][8];
#pragma unroll
        for (int i = 0; i < 8; ++i) {
            const v4u q = *(const v4u*)(f.A + (size_t)(r0 + i) * f.lda + k);
#pragma unroll
            for (int e = 0; e < 4; ++e) { a[i][2 * e] = __uint_as_float(q[e] << 16); a[i][2 * e + 1] = __uint_as_float(q[e] & 0xffff0000u); }
        }
#pragma unroll
        for (int e = 0; e < 8; ++e) {
            const float gk = f.gain ? f.gain[k + e] : 1.f;
#pragma unroll
            for (int d = 0; d < ND; ++d) {
                const float w = f.W[(size_t)(k + e) * f.ldw + wc[d]] * gk;
#pragma unroll
                for (int i = 0; i < 8; ++i) acc[d][i] = fmaf(a[i][e], w, acc[d][i]);
            }
        }
    }
#pragma unroll
    for (int i = 0; i < 8; ++i) { float v[ND];
#pragma unroll
        for (int d = 0; d < ND; ++d) v[d] = acc[d][i];
        f.out(r0 + i, cc, v, act); }
}
struct FBase { const bf16_t* A; int lda; const float* W; int ldw; const float* gain; int K; int ncols; };
struct F_LAT : FBase { int cbase; bf16_t* dst; float* ssq; int which;
    __device__ int wcol(int, int c) const { return cbase + c; }
    __device__ void out(int row, int c, const float (&v)[1], bool) const { dst[(size_t)row * 512 + c] = f2bf(v[0]); const float s = wave_sum(v[0] * v[0]); if ((threadIdx.x & 63) == 0) atomicAdd(ssq + row * 2 + which, s); } };
struct F_KR : FBase { bf16_t* dst; const float2* rope;
    __device__ int wcol(int d, int c) const { return C_KR + 32 * d + c; }
    __device__ void out(int row, int c, const float (&v)[2], bool act) const { if (!act) return; const float2 cs = rope[row * 32 + c];
        dst[(size_t)row * 64 + c] = f2bf(v[0] * cs.x - v[1] * cs.y); dst[(size_t)row * 64 + 32 + c] = f2bf(v[0] * cs.y + v[1] * cs.x); } };
struct F_ACT : FBase { int cbase; bf16_t* dst; int mode;
    __device__ int wcol(int, int c) const { return cbase + c; }
    __device__ void out(int row, int c, const float (&v)[1], bool) const { dst[(size_t)row * DM + c] = f2bf(mode == 0 ? silu_f(v[0]) : sigm_f(v[0])); } };
struct F_CV : FBase { bf16_t* U; bf16_t* T;
    __device__ int wcol(int d, int c) const { return (d == 0 ? C_CIN : d == 1 ? C_BG : d == 2 ? C_CG : C_ZC) + c; }
    __device__ void out(int row, int c, const float (&v)[4], bool) const { U[(size_t)row * DM + c] = f2bf(v[2] * v[0]); T[(size_t)row * DM + c] = f2bf(v[1] * silu_f(v[3])); } };
struct F_QN : FBase { bf16_t* dst; const float* ssq;
    __device__ int wcol(int, int c) const { return 192 * (c >> 7) + (c & 127); }
    __device__ void out(int row, int c, const float (&v)[1], bool) const { const float r = rsqrtf(ssq[row * 2] * (1.f / QL) + RMS_EPS); dst[(size_t)row * 2048 + c] = f2bf(v[0] * r * QSCALE); } };
struct F_QR : FBase { bf16_t* dst; const float* ssq; const float2* rope;
    __device__ int wcol(int d, int c) const { return 192 * (c >> 5) + 128 + 32 * d + (c & 31); }
    __device__ void out(int row, int c, const float (&v)[2], bool) const { const float r = rsqrtf(ssq[row * 2] * (1.f / QL) + RMS_EPS) * QSCALE; const float2 cs = rope[row * 32 + (c & 31)];
        const int h = c >> 5, i = c & 31; const float x1 = v[0] * r, x2 = v[1] * r;
        dst[(size_t)row * 1024 + 64 * h + i] = f2bf(x1 * cs.x - x2 * cs.y); dst[(size_t)row * 1024 + 64 * h + 32 + i] = f2bf(x1 * cs.y + x2 * cs.x); } };
struct F_KV : FBase { bf16_t* dst; const float* ssq; int off;
    __device__ int wcol(int, int c) const { return 256 * (c >> 7) + off + (c & 127); }
    __device__ void out(int row, int c, const float (&v)[1], bool) const { const float r = rsqrtf(ssq[row * 2 + 1] * (1.f / KVL) + RMS_EPS); dst[(size_t)row * 2048 + c] = f2bf(v[0] * r); } };
struct F_Y1 : FBase { float* tmp; const bf16_t* sg;
    __device__ int wcol(int, int c) const { return c; }
    __device__ void out(int row, int c, const float (&v)[1], bool) const { tmp[(size_t)row * DM + c] = v[0] * bf2f(sg[(size_t)row * DM + c]); } };
struct F_Y2 : FBase { const float* tmp; const bf16_t* sg; bf16_t* mg;
    __device__ int wcol(int, int c) const { return c; }
    __device__ void out(int row, int c, const float (&v)[1], bool) const { mg[(size_t)row * DM + c] = f2bf(tmp[(size_t)row * DM + c] + v[0] * bf2f(sg[(size_t)row * DM + c])); } };
struct F_OUT : FBase { float* outf;
    __device__ int wcol(int, int c) const { return c; }
    __device__ void out(int row, int c, const float (&v)[1], bool) const { outf[(size_t)row * DM + c] = v[0]; } };

__global__ void __launch_bounds__(256) k_conv(const bf16_t* U, const bf16_t* T, const float* cw, bf16_t* AC) {
    const size_t i = (size_t)blockIdx.x * 256 + threadIdx.x;
    const int s = (int)(i / DM), c = (int)(i % DM);
    const float u0 = bf2f(U[i]), u1 = s >= 1 ? bf2f(U[i - DM]) : 0.f, u2 = s >= 2 ? bf2f(U[i - 2 * DM]) : 0.f;
    const float cv = cw[c] * u2 + cw[DM + c] * u1 + cw[2 * DM + c] * u0;
    AC[i] = f2bf(bf2f(T[i]) * cv);
}

constexpr int NA_LDS = (64 * 193 * 2 + 64 * 132 + 64 * 65) * 4;
__global__ void __launch_bounds__(256) nv_attn(const bf16_t* QN, const bf16_t* QR, const bf16_t* KN, const bf16_t* KR, const bf16_t* V, const bf16_t* ZS, bf16_t* AO) {
    extern __shared__ __attribute__((aligned(16))) float sm[];
    float* Qs = sm; float* Ks = Qs + 64 * 193; float* Vs = Ks + 64 * 193; float* Ps = Vs + 64 * 132;
    const int qb = blockIdx.x, h = blockIdx.y, tid = threadIdx.x, r = tid >> 2, qq = tid & 3, q0 = qb * 64;
    for (int i = tid; i < 64 * 192; i += 256) { const int rr = i / 192, d = i % 192;
        Qs[rr * 193 + d] = d < 128 ? bf2f(QN[(size_t)(q0 + rr) * 2048 + h * 128 + d]) : bf2f(QR[(size_t)(q0 + rr) * 1024 + h * 64 + d - 128]); }
    float m = -1e30f, l = 0.f, o[32];
#pragma unroll
    for (int d = 0; d < 32; ++d) o[d] = 0.f;
    for (int kt = 0; kt <= qb; ++kt) {
        __syncthreads();
        const int k0 = kt * 64;
        for (int i = tid; i < 64 * 192; i += 256) { const int rr = i / 192, d = i % 192;
            Ks[rr * 193 + d] = d < 128 ? bf2f(KN[(size_t)(k0 + rr) * 2048 + h * 128 + d]) : bf2f(KR[(size_t)(k0 + rr) * 64 + d - 128]); }
        for (int i = tid; i < 64 * 128; i += 256) { const int rr = i >> 7, d = i & 127; Vs[rr * 132 + (d >> 5) * 33 + (d & 31)] = bf2f(V[(size_t)(k0 + rr) * 2048 + h * 128 + d]); }
        __syncthreads();
        float s[16]; float mx = -INFINITY;
#pragma unroll
        for (int j = 0; j < 16; ++j) { const int key = 4 * j + qq; float a = 0.f;
            for (int d = 0; d < 192; ++d) a = fmaf(Qs[r * 193 + d], Ks[key * 193 + d], a);
            if (k0 + key > q0 + r) a = -INFINITY;
            s[j] = a; mx = fmaxf(mx, a); }
        mx = fmaxf(mx, __shfl_xor(mx, 1)); mx = fmaxf(mx, __shfl_xor(mx, 2));
        const float mn = fmaxf(m, mx), alpha = exp2f(m - mn); m = mn;
        float ps = 0.f;
#pragma unroll
        for (int j = 0; j < 16; ++j) { const float p = exp2f(s[j] - mn); ps += p; Ps[r * 65 + 4 * j + qq] = p; }
        ps += __shfl_xor(ps, 1); ps += __shfl_xor(ps, 2);
        l = l * alpha + ps;
        __syncthreads();
#pragma unroll
        for (int d = 0; d < 32; ++d) o[d] *= alpha;
        for (int key = 0; key < 64; ++key) { const float p = Ps[r * 65 + key];
#pragma unroll
            for (int d = 0; d < 32; ++d) o[d] = fmaf(p, Vs[key * 132 + qq * 33 + d], o[d]); }
    }
    const float li = 1.f / l;
#pragma unroll
    for (int d = 0; d < 32; ++d) { const size_t idx = (size_t)(q0 + r) * 2048 + h * 128 + qq * 32 + d; AO[idx] = f2bf(o[d] * li * bf2f(ZS[idx])); }
}

__global__ void __launch_bounds__(256) k_final(const float* x, const float* outf, const float* g, float* out) {
    const int row = blockIdx.x * 4 + (threadIdx.x >> 6), lane = threadIdx.x & 63;
    const float4* yr = (const float4*)(outf + (size_t)row * DM); const float4* xr = (const float4*)(x + (size_t)row * DM);
    float4 v[8]; float s = 0.f;
#pragma unroll
    for (int j = 0; j < 8; ++j) { v[j] = yr[lane + 64 * j]; s += v[j].x * v[j].x + v[j].y * v[j].y + v[j].z * v[j].z + v[j].w * v[j].w; }
    const float r = rsqrtf(wave_sum(s) * (1.f / DM) + RMS_EPS);
#pragma unroll
    for (int j = 0; j < 8; ++j) { const float4 gg = ((const float4*)g)[lane + 64 * j], xx = xr[lane + 64 * j];
        float4 o; o.x = xx.x + v[j].x * r * gg.x; o.y = xx.y + v[j].y * r * gg.y; o.z = xx.z + v[j].z * r * gg.z; o.w = xx.w + v[j].w * r * gg.w;
        ((float4*)(out + (size_t)row * DM))[lane + 64 * j] = o; }
}


template <int ND, class F> static void run_dots(const F& f, hipStream_t st) {
    hipLaunchKernelGGL((nv_dots<ND, F>), dim3((f.ncols + 255) / 256, S / 8), dim3(256), 0, st, f);
}
#ifndef IMPL_MASK
#define IMPL_MASK 0x7F
#endif
extern "C" void kernel_launch(void* const* d_in, const int* in_sizes, int n_in, void* d_out, int out_size, void* d_ws, size_t ws_size, hipStream_t stream) {
    static int grid = 0;
    if (grid == 0) {
        if (n_in != 13 || in_sizes[0] != S * DM || in_sizes[3] != DM * IN_TOTAL || out_size != S * DM || ws_size < WS_END) {
            fprintf(stderr, "kernel_launch: unexpected shapes / workspace (n_in %d, ws %zu, need %zu)\n", n_in, ws_size, (size_t)WS_END); grid = -1; return; }
        int dev = 0, cus = 0, per_cu = 0;
        if (hipGetDevice(&dev) != hipSuccess || hipDeviceGetAttribute(&cus, hipDeviceAttributeMultiprocessorCount, dev) != hipSuccess) { grid = -1; return; }
        if (hipFuncSetAttribute((const void*)mk_fwd, hipFuncAttributeMaxDynamicSharedMemorySize, LDS_BYTES) != hipSuccess) { fprintf(stderr, "kernel_launch: hipFuncSetAttribute failed\n"); grid = -1; return; }
        (void)hipFuncSetAttribute((const void*)nv_attn, hipFuncAttributeMaxDynamicSharedMemorySize, NA_LDS);
        if (hipOccupancyMaxActiveBlocksPerMultiprocessor(&per_cu, (const void*)mk_fwd, NWAVES * 64, LDS_BYTES) != hipSuccess || per_cu < 1) { fprintf(stderr, "kernel_launch: occupancy query says %d\n", per_cu); per_cu = 1; }
        (void)hipGetLastError();
        grid = cus * 1;
        if (per_cu < 1) grid = -1;
    }
    if (grid < 0) return;
    if (hipMemsetAsync((char*)d_ws + WS_CTL, 0, CTL_ZERO_BYTES, stream) != hipSuccess) { fprintf(stderr, "kernel_launch: memset failed\n"); return; }
    Args a; memset(&a, 0, sizeof a);
    for (int i = 0; i < 13; ++i) a.in[i] = (const float*)d_in[i];
    a.out = (float*)d_out; a.ws = (unsigned char*)d_ws;
    if (MK_N_LAUNCHES == 1 && (IMPL_MASK & 0x7F) == 0x7F) {
        a.ph_lo = 0; a.ph_hi = NPHASE; a.li = 0;
        void* kargs[] = {&a};
        hipError_t e = hipLaunchCooperativeKernel((const void*)mk_fwd, dim3(grid), dim3(NWAVES * 64), kargs, LDS_BYTES, stream);
        if (e != hipSuccess) fprintf(stderr, "kernel_launch: cooperative launch failed: %s (grid %d)\n", hipGetErrorString(e), grid);
        return;
    }
    const float* x = (const float*)d_in[0]; const int* pos = (const int*)d_in[1]; const float* g_pre = (const float*)d_in[2]; const float* w_in = (const float*)d_in[3];
    const float* g_q = (const float*)d_in[4]; const float* w_qb = (const float*)d_in[5]; const float* g_kv = (const float*)d_in[6]; const float* w_kvb = (const float*)d_in[7];
    const float* conv_w = (const float*)d_in[8]; const float* w_om = (const float*)d_in[9]; const float* w_oc = (const float*)d_in[10]; const float* w_out = (const float*)d_in[11];
    const float* g_post = (const float*)d_in[12];
    unsigned char* ws = (unsigned char*)d_ws;
    float* ssq = (float*)(ws + WS_SSQ); float2* rope = (float2*)(ws + WS_ROPE);
    bf16_t *H = (bf16_t*)(ws + WS_H), *AO = (bf16_t*)(ws + WS_AO), *QA = (bf16_t*)(ws + WS_QA), *CKV = (bf16_t*)(ws + WS_CKV), *KR = (bf16_t*)(ws + WS_KR);
    bf16_t *ZS = (bf16_t*)(ws + WS_ZS), *U = (bf16_t*)(ws + WS_U), *T = (bf16_t*)(ws + WS_T), *SG1 = (bf16_t*)(ws + WS_SG1), *SG2 = (bf16_t*)(ws + WS_SG2);
    bf16_t *QN = (bf16_t*)(ws + WS_QN), *QR = (bf16_t*)(ws + WS_QR), *KN = (bf16_t*)(ws + WS_KN), *V = (bf16_t*)(ws + WS_V), *AC = (bf16_t*)(ws + WS_AC), *MG = (bf16_t*)(ws + WS_MG);
    float* OUTF = (float*)(ws + WS_OUTF);
    for (int k = 0; k < NPHASE; ++k) {
        if ((IMPL_MASK >> k) & 1) { a.ph_lo = k; a.ph_hi = k + 1; a.li = 0; hipLaunchKernelGGL(mk_fwd, dim3(grid), dim3(NWAVES * 64), LDS_BYTES, stream, a); continue; }
        switch (k) {
        case 0: hipLaunchKernelGGL(k_prep_misc, dim3(S * 32 / 256), dim3(256), 0, stream, pos, rope, ssq + S * 2);
                hipLaunchKernelGGL(k_xnorm, dim3(S / 4), dim3(256), 0, stream, x, g_pre, H); break;
        case 1: { { F_LAT f; memset(&f, 0, sizeof f); f.A = H; f.lda = DM; f.W = w_in; f.ldw = IN_TOTAL; f.gain = nullptr; f.K = DM; f.ncols = 512; f.cbase = C_QA; f.dst = QA; f.ssq = ssq; f.which = 0; run_dots<1>(f, stream);
                    f.cbase = C_CKV; f.dst = CKV; f.which = 1; run_dots<1>(f, stream); }
                  { F_KR f; memset(&f, 0, sizeof f); f.A = H; f.lda = DM; f.W = w_in; f.ldw = IN_TOTAL; f.gain = nullptr; f.K = DM; f.ncols = 32; f.dst = KR; f.rope = rope; run_dots<2>(f, stream); }
                  { F_ACT f; memset(&f, 0, sizeof f); f.A = H; f.lda = DM; f.W = w_in; f.ldw = IN_TOTAL; f.gain = nullptr; f.K = DM; f.ncols = DM; f.cbase = C_ZM; f.dst = ZS; f.mode = 0; run_dots<1>(f, stream);
                    f.cbase = C_GM; f.dst = SG1; f.mode = 1; run_dots<1>(f, stream);
                    f.cbase = C_GC; f.dst = SG2; f.mode = 1; run_dots<1>(f, stream); }
                  { F_CV f; memset(&f, 0, sizeof f); f.A = H; f.lda = DM; f.W = w_in; f.ldw = IN_TOTAL; f.gain = nullptr; f.K = DM; f.ncols = DM; f.U = U; f.T = T; run_dots<4>(f, stream); } } break;
        case 2: { { F_QN f; memset(&f, 0, sizeof f); f.A = QA; f.lda = QL; f.W = w_qb; f.ldw = 3072; f.gain = g_q; f.K = QL; f.ncols = 2048; f.dst = QN; f.ssq = ssq; run_dots<1>(f, stream); }
                  { F_QR f; memset(&f, 0, sizeof f); f.A = QA; f.lda = QL; f.W = w_qb; f.ldw = 3072; f.gain = g_q; f.K = QL; f.ncols = 512; f.dst = QR; f.ssq = ssq; f.rope = rope; run_dots<2>(f, stream); }
                  { F_KV f; memset(&f, 0, sizeof f); f.A = CKV; f.lda = KVL; f.W = w_kvb; f.ldw = 4096; f.gain = g_kv; f.K = KVL; f.ncols = 2048; f.dst = KN; f.ssq = ssq; f.off = 0; run_dots<1>(f, stream);
                    f.dst = V; f.off = 128; run_dots<1>(f, stream); }
                  hipLaunchKernelGGL(k_conv, dim3(S * DM / 256), dim3(256), 0, stream, U, T, conv_w, AC); } break;
        case 3: hipLaunchKernelGGL(nv_attn, dim3(S / 64, NH), dim3(256), NA_LDS, stream, QN, QR, KN, KR, V, ZS, AO); break;
        case 4: { { F_Y1 f; memset(&f, 0, sizeof f); f.A = AO; f.lda = DM; f.W = w_om; f.ldw = DM; f.gain = nullptr; f.K = DM; f.ncols = DM; f.tmp = OUTF; f.sg = SG1; run_dots<1>(f, stream); }
                  { F_Y2 f; memset(&f, 0, sizeof f); f.A = AC; f.lda = DM; f.W = w_oc; f.ldw = DM; f.gain = nullptr; f.K = DM; f.ncols = DM; f.tmp = OUTF; f.sg = SG2; f.mg = MG; run_dots<1>(f, stream); } } break;
        case 5: { F_OUT f; memset(&f, 0, sizeof f); f.A = MG; f.lda = DM; f.W = w_out; f.ldw = DM; f.gain = nullptr; f.K = DM; f.ncols = DM; f.outf = OUTF; run_dots<1>(f, stream); } break;
        default: hipLaunchKernelGGL(k_final, dim3(S / 4), dim3(256), 0, stream, x, OUTF, g_post, (float*)d_out); break;
        }
    }
}
```
